# Optimizing an MI355X kernel written in HIP

```python
import jax, jax.numpy as jnp
from jax import lax
import numpy as np

D_MODEL = 1024
BATCH = 2
SEQ = 8192
DEPTH = 4
DEC_BATCH = 128
DEC_SEQ = 8
PAST_LEN = 8192
PAGE_SIZE = 128

N_MIXERS = 2
N_HEADS = 16
N_KV_HEADS = 4
HEAD_DIM = 64
Q_PER_KV = N_HEADS // N_KV_HEADS
WINDOW = 128
BLOCK = 128
ROT_DIM = HEAD_DIM // 4
ROPE_THETA = 500000.0
CHUNK = 128
SGU_GROUPS = 4
D_SGU = 2 * D_MODEL
SGU_GROUP_DIM = D_SGU // SGU_GROUPS
D_FF = 2816
CONV_W = 3
N_ATTN_LAYERS = (DEPTH + 1) // 2
N_SGU_LAYERS = DEPTH // 2
QKV_DIM = (N_HEADS + 2 * N_KV_HEADS) * HEAD_DIM
EPS = 1e-6

kernel_name = 'hybrid_swa_sink_sgu_convffn_step'


def rmsnorm(x, g):
    xf = x.astype(jnp.float32)
    y = xf * lax.rsqrt(jnp.mean(xf * xf, -1, keepdims=True) + EPS)
    return (y * g.astype(jnp.float32)).astype(x.dtype)


def layernorm(x, g, b):
    xf = x.astype(jnp.float32)
    mu = jnp.mean(xf, -1, keepdims=True)
    xc = xf - mu
    y = xc * lax.rsqrt(jnp.mean(xc * xc, -1, keepdims=True) + EPS)
    return (y * g.astype(jnp.float32) + b.astype(jnp.float32)).astype(x.dtype)


def rope(x, pos):
    half = ROT_DIM // 2
    inv = ROPE_THETA ** (-jnp.arange(0, ROT_DIM, 2, dtype=jnp.float32) / ROT_DIM)
    ang = pos.astype(jnp.float32)[:, None] * inv[None, :]
    cos = jnp.cos(ang)[:, None, :]
    sin = jnp.sin(ang)[:, None, :]
    xf = x.astype(jnp.float32)
    x1 = xf[..., :half]
    x2 = xf[..., half:ROT_DIM]
    out = jnp.concatenate([x1 * cos - x2 * sin, x2 * cos + x1 * sin, xf[..., ROT_DIM:]], -1)
    return out.astype(x.dtype)


def qkv_rope(h, w, b, pos):
    B, T = h.shape[:2]
    y = h @ w + b
    nq = N_HEADS * HEAD_DIM
    nk = N_KV_HEADS * HEAD_DIM
    q = y[..., :nq].reshape(B, T, N_HEADS, HEAD_DIM)
    k = y[..., nq:nq + nk].reshape(B, T, N_KV_HEADS, HEAD_DIM)
    v = y[..., nq + nk:].reshape(B, T, N_KV_HEADS, HEAD_DIM)
    return rope(q, pos), rope(k, pos), v


def sink_softmax(s, sink, mask):
    s = jnp.where(mask, s, -jnp.inf)
    sk = sink.astype(jnp.float32)[:, :, None, None]
    m = jnp.maximum(s.max(-1, keepdims=True), sk)
    p = jnp.exp(s - m)
    return p / (p.sum(-1, keepdims=True) + jnp.exp(sk - m))


def window_attn_prompt(q, k, v, sink):
    B, S = q.shape[:2]
    nb = S // BLOCK
    qb = q.reshape(B, nb, BLOCK, N_KV_HEADS, Q_PER_KV, HEAD_DIM)
    kb = k.reshape(B, nb, BLOCK, N_KV_HEADS, HEAD_DIM)
    vb = v.reshape(B, nb, BLOCK, N_KV_HEADS, HEAD_DIM)

    def with_prev(xb):
        prev = jnp.pad(xb, ((0, 0), (1, 0), (0, 0), (0, 0), (0, 0)))[:, :-1]
        return jnp.concatenate([prev, xb], axis=2)

    kc, vc = with_prev(kb), with_prev(vb)
    s = jnp.einsum('bnqkgd,bnskd->bnkgqs', qb, kc, preferred_element_type=jnp.float32) * (HEAD_DIM ** -0.5)
    i = jnp.arange(BLOCK)[:, None]
    j = jnp.arange(2 * BLOCK)[None, :]
    diff = BLOCK + i - j
    band = (diff >= 0) & (diff <= WINDOW)
    valid = (jnp.arange(nb) > 0)[:, None, None] | (j >= BLOCK)[None]
    mask = (band[None] & valid)[None, :, None, None]
    p = sink_softmax(s, sink.reshape(N_KV_HEADS, Q_PER_KV), mask)
    o = jnp.einsum('bnkgqs,bnskd->bnqkgd', p.astype(vc.dtype), vc)
    return o.reshape(B, S, N_HEADS * HEAD_DIM)


def window_attn_sample(q, k_new, v_new, k_cache, v_cache, sink):
    DB, T = q.shape[:2]
    W = k_cache.shape[1]
    kc = jnp.concatenate([k_cache.astype(k_new.dtype), k_new], 1)
    vc = jnp.concatenate([v_cache.astype(v_new.dtype), v_new], 1)
    qg = q.reshape(DB, T, N_KV_HEADS, Q_PER_KV, HEAD_DIM)
    s = jnp.einsum('btkgd,bskd->bkgts', qg, kc, preferred_element_type=jnp.float32) * (HEAD_DIM ** -0.5)
    t = jnp.arange(T)[:, None]
    j = jnp.arange(W + T)[None, :]
    diff = W + t - j
    mask = (diff >= 0) & (diff <= WINDOW)
    p = sink_softmax(s, sink.reshape(N_KV_HEADS, Q_PER_KV), mask)
    o = jnp.einsum('bkgts,bskd->btkgd', p.astype(vc.dtype), vc)
    return o.reshape(DB, T, N_HEADS * HEAD_DIM), kc[:, -W:], vc[:, -W:]


def sgu_mix(h, w_in, b_in, ln_g, ln_b, w_sp, b_sp, w_out):
    B, T = h.shape[:2]
    tc = min(T, CHUNK)
    z = jax.nn.gelu(h @ w_in + b_in)
    u, v = jnp.split(z, 2, axis=-1)
    v = layernorm(v, ln_g, ln_b)
    tri = jnp.tril(jnp.ones((CHUNK, CHUNK), w_sp.dtype))
    wm = (w_sp * tri)[:, :tc, :tc]
    vb = v.reshape(B, T // tc, tc, SGU_GROUPS, SGU_GROUP_DIM)
    mixed = jnp.einsum('gts,bnsgc->bntgc', wm, vb) + b_sp[:, :tc].T[None, None, :, :, None]
    out = (u * mixed.reshape(B, T, D_SGU)) @ w_out
    return out, v


def conv_ffn(h, past, w_up, conv_w, conv_b, w_down):
    T = h.shape[1]
    a = h @ w_up
    ap = jnp.concatenate([past.astype(a.dtype), a], 1)
    conv = sum(conv_w[j] * ap[:, j:j + T] for j in range(CONV_W)) + conv_b
    g, u = jnp.split(conv, 2, axis=-1)
    y = (jax.nn.silu(g) * u) @ w_down
    return y, ap[:, T:]


def trunk(x, c, start, cache_k, cache_v, state_conv, w_ada, b_ada, norm_mix, norm_ffn,
          w_qkv, b_qkv, attn_sink, w_o, w_sgu_in, b_sgu_in, sgu_ln_g, sgu_ln_b,
          w_spatial, b_spatial, w_sgu_out, w_up, conv_w, conv_b, w_down, norm_final):
    B, T = x.shape[:2]
    pos = start + jnp.arange(T)
    new_k, new_v, new_conv, new_sgu = [], [], [], []
    for l in range(DEPTH):
        mod = (jax.nn.silu(c) @ w_ada[l] + b_ada[l]).astype(x.dtype)[:, None, :]
        sh1, sc1, g1, sh2, sc2, g2 = jnp.split(mod, 6, axis=-1)
        h = rmsnorm(x, norm_mix[l]) * (1 + sc1) + sh1
        idx = l // N_MIXERS
        if l % N_MIXERS == 0:
            q, k, v = qkv_rope(h, w_qkv[idx], b_qkv[idx], pos)
            if cache_k is None:
                o = window_attn_prompt(q, k, v, attn_sink[idx])
                wkeep = min(WINDOW, T)
                nk, nv = k[:, T - wkeep:], v[:, T - wkeep:]
            else:
                o, nk, nv = window_attn_sample(q, k, v, cache_k[idx], cache_v[idx], attn_sink[idx])
            new_k.append(nk)
            new_v.append(nv)
            mix = o @ w_o[idx]
        else:
            mix, vrows = sgu_mix(h, w_sgu_in[idx], b_sgu_in[idx], sgu_ln_g[idx], sgu_ln_b[idx],
                                 w_spatial[idx], b_spatial[idx], w_sgu_out[idx])
            if cache_k is not None:
                new_sgu.append(vrows)
        x = x + g1 * mix
        h = rmsnorm(x, norm_ffn[l]) * (1 + sc2) + sh2
        past = jnp.zeros((B, CONV_W - 1, 2 * D_FF), x.dtype) if state_conv is None else state_conv[l]
        f, st = conv_ffn(h, past, w_up[l], conv_w[l], conv_b[l], w_down[l])
        new_conv.append(st)
        x = x + g2 * f
    y = rmsnorm(x, norm_final)
    return y, jnp.stack(new_k), jnp.stack(new_v), jnp.stack(new_conv), new_sgu


def setup_inputs(seed: int = 0) -> dict:
    key = jax.random.key(seed)
    ks = jax.random.split(key, 32)
    f32 = jnp.float32

    def nrm(k, shape, scale):
        return jax.random.normal(k, shape, f32) * scale

    cache_win = min(WINDOW, PAST_LEN)
    return {
        'x_prompt': nrm(ks[0], (BATCH, SEQ, D_MODEL), 1.0),
        'x_sample': nrm(ks[1], (DEC_BATCH, DEC_SEQ, D_MODEL), 1.0),
        'c_prompt': nrm(ks[2], (BATCH, D_MODEL), 1.0),
        'c_sample': nrm(ks[3], (DEC_BATCH, D_MODEL), 1.0),
        'cache_k': nrm(ks[4], (N_ATTN_LAYERS, DEC_BATCH, cache_win, N_KV_HEADS, HEAD_DIM), 1.0),
        'cache_v': nrm(ks[5], (N_ATTN_LAYERS, DEC_BATCH, cache_win, N_KV_HEADS, HEAD_DIM), 1.0),
        'state_conv': nrm(ks[6], (DEPTH, DEC_BATCH, CONV_W - 1, 2 * D_FF), 1.0),
        'w_ada': nrm(ks[7], (DEPTH, D_MODEL, 6 * D_MODEL), 0.5 * D_MODEL ** -0.5),
        'b_ada': nrm(ks[8], (DEPTH, 6 * D_MODEL), 0.02),
        'norm_mix': 1.0 + nrm(ks[9], (DEPTH, D_MODEL), 0.05),
        'norm_ffn': 1.0 + nrm(ks[10], (DEPTH, D_MODEL), 0.05),
        'w_qkv': nrm(ks[11], (N_ATTN_LAYERS, D_MODEL, QKV_DIM), D_MODEL ** -0.5),
        'b_qkv': nrm(ks[12], (N_ATTN_LAYERS, QKV_DIM), 0.02),
        'attn_sink': nrm(ks[13], (N_ATTN_LAYERS, N_HEADS), 0.5),
        'w_o': nrm(ks[14], (N_ATTN_LAYERS, N_HEADS * HEAD_DIM, D_MODEL), (N_HEADS * HEAD_DIM) ** -0.5),
        'w_sgu_in': nrm(ks[15], (N_SGU_LAYERS, D_MODEL, 2 * D_SGU), D_MODEL ** -0.5),
        'b_sgu_in': nrm(ks[16], (N_SGU_LAYERS, 2 * D_SGU), 0.02),
        'sgu_ln_g': 1.0 + nrm(ks[17], (N_SGU_LAYERS, D_SGU), 0.05),
        'sgu_ln_b': nrm(ks[18], (N_SGU_LAYERS, D_SGU), 0.02),
        'w_spatial': nrm(ks[19], (N_SGU_LAYERS, SGU_GROUPS, CHUNK, CHUNK), CHUNK ** -0.5),
        'b_spatial': 1.0 + nrm(ks[20], (N_SGU_LAYERS, SGU_GROUPS, CHUNK), 0.1),
        'w_sgu_out': nrm(ks[21], (N_SGU_LAYERS, D_SGU, D_MODEL), D_SGU ** -0.5),
        'w_up': nrm(ks[22], (DEPTH, D_MODEL, 2 * D_FF), D_MODEL ** -0.5),
        'conv_w': nrm(ks[23], (DEPTH, CONV_W, 2 * D_FF), CONV_W ** -0.5),
        'conv_b': nrm(ks[24], (DEPTH, 2 * D_FF), 0.02),
        'w_down': nrm(ks[25], (DEPTH, D_FF, D_MODEL), D_FF ** -0.5),
        'norm_final': 1.0 + nrm(ks[26], (D_MODEL,), 0.05),
    }


def reference(x_prompt, x_sample, c_prompt, c_sample, cache_k, cache_v, state_conv,
              w_ada, b_ada, norm_mix, norm_ffn, w_qkv, b_qkv, attn_sink, w_o,
              w_sgu_in, b_sgu_in, sgu_ln_g, sgu_ln_b, w_spatial, b_spatial, w_sgu_out,
              w_up, conv_w, conv_b, w_down, norm_final):
    y_prompt, k_p, v_p, conv_p, _ = trunk(
        x_prompt, c_prompt, 0, None, None, None, w_ada, b_ada, norm_mix, norm_ffn,
        w_qkv, b_qkv, attn_sink, w_o, w_sgu_in, b_sgu_in, sgu_ln_g, sgu_ln_b,
        w_spatial, b_spatial, w_sgu_out, w_up, conv_w, conv_b, w_down, norm_final)
    y_sample, k_s, v_s, conv_s, sgu_rows = trunk(
        x_sample, c_sample, PAST_LEN, cache_k, cache_v, state_conv, w_ada, b_ada, norm_mix, norm_ffn,
        w_qkv, b_qkv, attn_sink, w_o, w_sgu_in, b_sgu_in, sgu_ln_g, sgu_ln_b,
        w_spatial, b_spatial, w_sgu_out, w_up, conv_w, conv_b, w_down, norm_final)
    sgu_v_s = jnp.stack(sgu_rows)
    return (y_prompt, y_sample, k_p, v_p, conv_p, k_s, v_s, conv_s, sgu_v_s)
```

```cpp
#include <hip/hip_runtime.h>
#include <hip/hip_cooperative_groups.h>
#include <cstdio>
#include <cstdint>
#include <cstring>
#include <cmath>
namespace cg = cooperative_groups;
namespace pg8 {
#define PG8_LAS __attribute__((address_space(3)))
typedef unsigned short bf16_t;
typedef short bf16x8 __attribute__((ext_vector_type(8)));
typedef float f32x4 __attribute__((ext_vector_type(4)));
typedef unsigned u32x4 __attribute__((ext_vector_type(4)));
constexpr int BM = 256, BK = 64, HALF = 128, HTB = HALF * BK * 2  , STAGE_BYTES = 8 * HTB, NXCD = 8, WGM = 8;

__host__ __device__ __forceinline__ int lds_byte(int r, int c) { const int st = (r >> 4) * 2 + (c >> 5), rr = r & 15, cc = c & 31, ob = rr * 64 + cc * 2; return st * 1024 + (ob ^ (((ob >> 9) & 1) << 5)); }
__host__ __device__ __forceinline__ void stage_rc(int b, int& R, int& C) { const int st = b / 1024, sb = b % 1024, swz = sb ^ (((sb >> 9) & 1) << 5); R = (st >> 1) * 16 + swz / 64; C = (st & 1) * 32 + (swz % 64) / 2; }
__host__ __device__ __forceinline__ int perm32(int rho) { const int n = rho >> 4, i = rho & 15; return 8 * (i >> 2) + 4 * n + (i & 3); }

struct Unit { int pm, pn, k0, nt; };
struct Gemm { const bf16_t* A; const bf16_t* Bt; int M, N, K; };

struct StaticOrder {
    int nM, nN, nwg, G, c;
    __host__ __device__ void init(int M, int N, int G_, int c_) { nM = M / BM; nN = N / BM; nwg = nM * nN; G = G_; c = c_; }
    __host__ __device__ bool next(int i, Unit& u) const {
        const long L = (long)i * G + c; if (L >= nwg) return false;
        int wgid = (int)L; { const int q = nwg / NXCD, r = nwg % NXCD, xcd = wgid % NXCD, off = wgid / NXCD; wgid = (xcd < r ? xcd * (q + 1) : r * (q + 1) + (xcd - r) * q) + off; }
        const int nig = WGM * nN, gid = wgid / nig, fm = gid * WGM, gsz = (nM - fm) < WGM ? (nM - fm) : WGM;
        u.pm = fm + ((wgid % nig) % gsz); u.pn = (wgid % nig) / gsz; u.k0 = 0; u.nt = 0; return true;
    }
    __device__ __forceinline__ void a_ready(const Unit&) const {}
    __device__ __forceinline__ void done(const Unit&) const {}
};

__device__ __forceinline__ unsigned cvt_pk_bf16(float lo, float hi) { unsigned r; asm volatile("v_cvt_pk_bf16_f32 %0, %1, %2" : "=v"(r) : "v"(lo), "v"(hi)); return r; }
typedef float f32x2 __attribute__((ext_vector_type(2)));
template <class Epi, class Sched, bool ALIGN_EPI = false, bool SP2 = false>
__device__ __forceinline__ void gemm_phase(PG8_LAS unsigned char* lds, const Gemm g, const Sched& S, const Epi& E) {
    int tid_ = threadIdx.x; asm volatile("" : "+v"(tid_));
    const int tid = tid_, wid = __builtin_amdgcn_readfirstlane(tid >> 6), lane = tid & 63, wr = wid >> 2, wc = wid & 3, fr = lane & 15, fq = lane >> 4;
    const int K = g.K, nt = K / BK;
    unsigned voffA[2], voffB[2];
#pragma unroll
    for (int i = 0; i < 2; ++i) { int R, C; stage_rc(tid * 16 + i * 8192, R, C); const int Rb = Epi::PERM ? ((R & ~31) + perm32(R & 31)) : R;
        voffA[i] = (unsigned)(R * K + C) * 2u; voffB[i] = (unsigned)(Rb * K + C) * 2u; }
    const size_t kstep = (size_t)(BK * 2);
    const size_t hstep = (size_t)HALF * K * 2;
    const size_t tstep = 2 * hstep;
    const unsigned ldsw = (unsigned)wid * 1024u;
    const int aoff = lds_byte(wr * 64 + fr, fq * 8), boff = lds_byte(wc * 32 + fr, fq * 8);
#define PG8_SA(b, h) (((b) * 2 + (h)) * HTB)
#define PG8_SB(b, h) ((4 + (b) * 2 + (h)) * HTB)
#define PG8_STAGE(bufoff, gbase, voff) do { _Pragma("unroll") for (int _i = 0; _i < 2; ++_i) \
        __builtin_amdgcn_global_load_lds((const unsigned*)((const char*)(gbase) + (voff)[_i]), (PG8_LAS unsigned*)(lds + (bufoff) + ldsw + _i * 8192), 16, 0, 0); } while (0)
#define PG8_LDA(dst, b, h) do { _Pragma("unroll") for (int m = 0; m < 4; ++m) _Pragma("unroll") for (int k = 0; k < 2; ++k) dst[m][k] = *(const PG8_LAS bf16x8*)(lds + PG8_SA(b, h) + aoff + m * 2048 + k * 1024); } while (0)
#define PG8_LDB(dst, b, h) do { _Pragma("unroll") for (int n = 0; n < 2; ++n) _Pragma("unroll") for (int k = 0; k < 2; ++k) dst[n][k] = *(const PG8_LAS bf16x8*)(lds + PG8_SB(b, h) + boff + n * 2048 + k * 1024); } while (0)
#define PG8_MMA(ai, bj, At, Bt) do { __builtin_amdgcn_s_setprio(1); _Pragma("unroll") for (int m = 0; m < 4; ++m) _Pragma("unroll") for (int n = 0; n < 2; ++n) _Pragma("unroll") for (int k = 0; k < 2; ++k) \
        acc[ai][bj][m][n] = __builtin_amdgcn_mfma_f32_16x16x32_bf16(Bt[n][k], At[m][k], acc[ai][bj][m][n], 0, 0, 0); __builtin_amdgcn_s_setprio(0); } while (0)
#define PG8_WAIT_V(n) asm volatile("s_waitcnt vmcnt(" #n ")" ::: "memory")
#define PG8_WAIT_L(n) asm volatile("s_waitcnt lgkmcnt(" #n ")" ::: "memory")
#define PG8_BAR __builtin_amdgcn_s_barrier()
#define PG8_SCHED __builtin_amdgcn_sched_barrier(0)
    Unit cur, nxt; int ui = 0;
    if (!S.next(0, cur)) return;
    f32x4 acc[2][2][4][2];
#pragma unroll
    for (int a = 0; a < 2; ++a)
#pragma unroll
        for (int b = 0; b < 2; ++b)
#pragma unroll
            for (int m = 0; m < 4; ++m)
#pragma unroll
                for (int n = 0; n < 2; ++n) acc[a][b][m][n] = (f32x4){0.f, 0.f, 0.f, 0.f};
    if constexpr (Epi::HAS_INIT) E.init(acc, cur, wr, wc, fr, fq);
    bf16x8 At[4][2], B0[2][2], B1[2][2];
    const char* cA = (const char*)g.A + (size_t)cur.pm * tstep + (size_t)cur.k0 * kstep; const char* cB = (const char*)g.Bt + (size_t)cur.pn * tstep + (size_t)cur.k0 * kstep;
    S.a_ready(cur);
    if constexpr (SP2) {
        PG8_STAGE(PG8_SB(0, 0), cB, voffB); PG8_STAGE(PG8_SB(0, 1), cB + hstep, voffB); PG8_STAGE(PG8_SA(0, 0), cA, voffA); PG8_STAGE(PG8_SA(0, 1), cA + hstep, voffA);
        if (wr == 1) PG8_BAR;
        PG8_WAIT_V(2); PG8_BAR;
        PG8_STAGE(PG8_SB(1, 0), cB + kstep, voffB); PG8_STAGE(PG8_SA(1, 0), cA + kstep, voffA); PG8_STAGE(PG8_SB(1, 1), cB + hstep + kstep, voffB);
        PG8_WAIT_V(6); PG8_BAR;
    } else {
        PG8_STAGE(PG8_SB(0, 0), cB, voffB); PG8_STAGE(PG8_SA(0, 0), cA, voffA); PG8_STAGE(PG8_SB(0, 1), cB + hstep, voffB); PG8_STAGE(PG8_SA(0, 1), cA + hstep, voffA);
        if (wr == 1) PG8_BAR;
        PG8_WAIT_V(4); PG8_BAR;
        PG8_STAGE(PG8_SB(1, 0), cB + kstep, voffB); PG8_STAGE(PG8_SA(1, 0), cA + kstep, voffA); PG8_STAGE(PG8_SB(1, 1), cB + hstep + kstep, voffB);
        PG8_WAIT_V(6); PG8_BAR;
    }
    for (;;) {
        const bool has_next = S.next(ui + 1, nxt);
        const char* nA = has_next ? (const char*)g.A + (size_t)nxt.pm * tstep + (size_t)nxt.k0 * kstep : cA; const char* nB = has_next ? (const char*)g.Bt + (size_t)nxt.pn * tstep + (size_t)nxt.k0 * kstep : cB;
        const int cnt = cur.nt ? cur.nt : nt;
        for (int t = 0; t < cnt; t += 2) {
            const bool last = (t == cnt - 2);
            const char* a1 = cA + (size_t)(t + 1) * kstep;
            const char* a2 = last ? nA : cA + (size_t)(t + 2) * kstep; const char* b2 = last ? nB : cB + (size_t)(t + 2) * kstep;
            const char* a3 = a2 + kstep; const char* b3 = b2 + kstep;
            if (last && has_next) S.a_ready(nxt);
            if constexpr (SP2) {
            PG8_LDB(B0, 0, 0); PG8_LDB(B1, 0, 1); PG8_SCHED; PG8_LDA(At, 0, 0); PG8_STAGE(PG8_SA(1, 1), a1 + hstep, voffA);
            PG8_WAIT_V(8); PG8_WAIT_L(0); PG8_BAR; PG8_MMA(0, 0, At, B0); PG8_MMA(0, 1, At, B1); PG8_BAR; PG8_SCHED;
            PG8_LDA(At, 0, 1); PG8_STAGE(PG8_SB(0, 0), b2, voffB); PG8_STAGE(PG8_SB(0, 1), b2 + hstep, voffB); PG8_STAGE(PG8_SA(0, 0), a2, voffA);
            PG8_WAIT_V(8); PG8_WAIT_L(0); PG8_BAR; PG8_MMA(1, 0, At, B0); PG8_MMA(1, 1, At, B1); PG8_BAR; PG8_SCHED;
            PG8_LDB(B0, 1, 0); PG8_LDB(B1, 1, 1); PG8_SCHED; PG8_LDA(At, 1, 0); PG8_STAGE(PG8_SA(0, 1), a2 + hstep, voffA);
            PG8_WAIT_V(8); PG8_WAIT_L(0); PG8_BAR; PG8_MMA(0, 0, At, B0); PG8_MMA(0, 1, At, B1); PG8_BAR; PG8_SCHED;
            PG8_LDA(At, 1, 1); PG8_STAGE(PG8_SB(1, 0), b3, voffB); PG8_STAGE(PG8_SB(1, 1), b3 + hstep, voffB); PG8_STAGE(PG8_SA(1, 0), a3, voffA);
            PG8_WAIT_V(8); PG8_WAIT_L(0); PG8_BAR; PG8_MMA(1, 0, At, B0); PG8_MMA(1, 1, At, B1); PG8_BAR; PG8_SCHED;
            } else {
            PG8_LDB(B0, 0, 0); PG8_SCHED; PG8_LDA(At, 0, 0); PG8_STAGE(PG8_SA(1, 1), a1 + hstep, voffA);
            PG8_WAIT_L(8); PG8_BAR; PG8_WAIT_L(0); PG8_MMA(0, 0, At, B0); PG8_BAR; PG8_SCHED;
            PG8_LDB(B1, 0, 1); PG8_STAGE(PG8_SB(0, 0), b2, voffB);
            PG8_BAR; PG8_WAIT_L(0); PG8_MMA(0, 1, At, B1); PG8_BAR;
            PG8_LDA(At, 0, 1); PG8_STAGE(PG8_SA(0, 0), a2, voffA);
            PG8_BAR; PG8_WAIT_L(0); PG8_MMA(1, 0, At, B0); PG8_BAR; PG8_SCHED;
            PG8_STAGE(PG8_SB(0, 1), b2 + hstep, voffB);
            PG8_WAIT_V(6); PG8_BAR; PG8_MMA(1, 1, At, B1); PG8_BAR;
            PG8_LDB(B0, 1, 0); PG8_SCHED; PG8_LDA(At, 1, 0); PG8_STAGE(PG8_SA(0, 1), a2 + hstep, voffA);
            PG8_WAIT_L(8); PG8_BAR; PG8_WAIT_L(0); PG8_MMA(0, 0, At, B0); PG8_BAR; PG8_SCHED;
            PG8_LDB(B1, 1, 1); PG8_STAGE(PG8_SB(1, 0), b3, voffB);
            PG8_BAR; PG8_WAIT_L(0); PG8_MMA(0, 1, At, B1); PG8_BAR;
            PG8_LDA(At, 1, 1); PG8_STAGE(PG8_SA(1, 0), a3, voffA);
            PG8_BAR; PG8_WAIT_L(0); PG8_MMA(1, 0, At, B0); PG8_BAR; PG8_SCHED;
            PG8_STAGE(PG8_SB(1, 1), b3 + hstep, voffB);
            PG8_WAIT_V(6); PG8_BAR; PG8_MMA(1, 1, At, B1); PG8_BAR;
            }
        }
        if constexpr (ALIGN_EPI) { if (wr == 0) PG8_BAR; }
        if constexpr (!Epi::AFTER_DRAIN) { E(acc, cur, wr, wc, fr, fq); S.done(cur); }
        if (!has_next) break;
#pragma unroll
        for (int a = 0; a < 2; ++a)
#pragma unroll
            for (int b = 0; b < 2; ++b)
#pragma unroll
                for (int m = 0; m < 4; ++m)
#pragma unroll
                    for (int n = 0; n < 2; ++n) acc[a][b][m][n] = (f32x4){0.f, 0.f, 0.f, 0.f};
        cur = nxt; cA = nA; cB = nB; ++ui;
        if constexpr (Epi::HAS_INIT) E.init(acc, cur, wr, wc, fr, fq);
        if constexpr (ALIGN_EPI) { if (wr == 1) PG8_BAR; }
    }
    PG8_WAIT_V(0);
    if constexpr (!ALIGN_EPI) { if (wr == 0) PG8_BAR; }
    PG8_BAR;
    if constexpr (Epi::AFTER_DRAIN) { E.fused(acc, cur, wr, wc, fr, fq, lds, wid, lane); S.done(cur); }
#undef PG8_SA
#undef PG8_SB
#undef PG8_STAGE
#undef PG8_LDA
#undef PG8_LDB
#undef PG8_MMA
#undef PG8_WAIT_V
#undef PG8_WAIT_L
#undef PG8_BAR
#undef PG8_SCHED
}
}

#ifndef MK_PER_PHASE
#define MK_PER_PHASE 0
#endif
using pg8::bf16_t; using pg8::bf16x8; using pg8::f32x4; using pg8::u32x4; using pg8::cvt_pk_bf16; using pg8::Unit;
#ifndef LAS
#define LAS __attribute__((address_space(3)))
#endif
typedef unsigned u32x2 __attribute__((ext_vector_type(2)));
constexpr int DM = 1024, MP = 16384, MS = 1024, M = MP + MS, SEQ = 8192, NSEQ = 130, DEPTH = 4;
constexpr int DFF = 2816, DFF2 = 5632, DSGU = 2048, QKVN = 1536, MODW = 6144 * DEPTH, NPOS = 8200;
constexpr float EPS = 1e-6f, LOG2E = 1.4426950408889634f, QSCALE = 0.125f * LOG2E;
constexpr int NWAVES = 8, NTHR = 512;
constexpr size_t O_Y = 0, O_KP = (size_t)M * DM, O_VP = O_KP + 131072, O_CP = O_VP + 131072, O_KS = O_CP + 90112,
                 O_VS = O_KS + 8388608, O_CS = O_VS + 8388608, O_SG = O_CS + 5767168, O_END = O_SG + 4194304;
constexpr size_t MiB = 1u << 20;
constexpr size_t WS_RSTAT = 128 * 1024  , WS_WTRI = 2 * MiB + 512 * 1024  ;
constexpr size_t WS_ROPE = 1 * MiB, WS_SC = 2 * MiB, WS_MOD = 3 * MiB, WS_WQKV = 16 * MiB, WS_WO = 22 * MiB, WS_WSI = 26 * MiB, WS_WSO = 42 * MiB,
                 WS_WUP = 50 * MiB, WS_WDN = 94 * MiB, WS_R2 = 116 * MiB, WS_R1 = 210 * MiB, WS_END = 397 * MiB;
constexpr size_t WS_PART = WS_R1 + 140 * MiB;
static_assert(WS_PART + 11 * (size_t)MS * DM * 4 <= WS_END, "partials");
static_assert(WS_R2 + (size_t)M * DFF * 2 <= WS_R1 && WS_R1 + (size_t)M * DFF2 * 2 <= WS_END && WS_MOD + (size_t)NSEQ * MODW * 4 <= WS_WQKV, "ws map");
constexpr int LDS_BYTES = 147456;

struct Params { const float* in[27]; float* out; unsigned char* ws; double inv[8]; int ph_lo, ph_hi; };
#define CAS __attribute__((address_space(4)))
typedef const CAS Params* PPtr;
enum { I_XP = 0, I_XS, I_CP, I_CS, I_CK, I_CV, I_SCONV, I_WADA, I_BADA, I_NMIX, I_NFFN, I_WQKV, I_BQKV, I_SINK, I_WO, I_WSI, I_BSI, I_LNG, I_LNB,
       I_WSP, I_BSP, I_WSO, I_WUP, I_CW, I_CB, I_WDN, I_NFIN };

__device__ __forceinline__ void row_info(int r, int& seq, int& t) { if (r < MP) { seq = r >> 13; t = r & 8191; } else { const int q = r - MP; seq = 2 + (q >> 3); t = q & 7; } }
__device__ __forceinline__ float wave_sum(float v) {
#pragma unroll
    for (int o = 1; o < 64; o <<= 1) v += __shfl_xor(v, o);
    return v;
}
__device__ __forceinline__ float bf2f(unsigned h) { return __uint_as_float(h << 16); }
__device__ __forceinline__ u32x4 pack8(const f32x4 a, const f32x4 b) { u32x4 w; w.x = cvt_pk_bf16(a[0], a[1]); w.y = cvt_pk_bf16(a[2], a[3]); w.z = cvt_pk_bf16(b[0], b[1]); w.w = cvt_pk_bf16(b[2], b[3]); return w; }

#ifndef NT_STORES
#define NT_STORES 0
#endif
__device__ __forceinline__ void st16(void* p, u32x4 v) { if (NT_STORES) __builtin_nontemporal_store(v, (u32x4*)p); else *(u32x4*)p = v; }
__device__ __forceinline__ void st8(void* p, u32x2 v) { if (NT_STORES) __builtin_nontemporal_store(v, (u32x2*)p); else *(u32x2*)p = v; }
struct EpiAda { static constexpr bool PERM = true, AFTER_DRAIN = false, HAS_INIT = false; float* mod; const float* bias;
    __device__ __forceinline__ void operator()(const f32x4 (&acc)[2][2][4][2], const Unit& u, int wr, int wc, int fr, int fq) const {
        const int row0 = u.pm * 256 + wr * 64 + fr, col0 = u.pn * 256 + wc * 32 + 8 * fq;
        f32x4 bv[2][2];
#pragma unroll
        for (int bj = 0; bj < 2; ++bj)
#pragma unroll
            for (int n = 0; n < 2; ++n) bv[bj][n] = *(const f32x4*)(bias + col0 + bj * 128 + 4 * n);
#pragma unroll
        for (int ai = 0; ai < 2; ++ai)
#pragma unroll
            for (int m = 0; m < 4; ++m) { const int r = row0 + ai * 128 + m * 16; if (r < NSEQ) {
#pragma unroll
                for (int bj = 0; bj < 2; ++bj) { float* d = mod + (size_t)r * MODW + col0 + bj * 128;
                    *(f32x4*)d = acc[ai][bj][m][0] + bv[bj][0]; *(f32x4*)(d + 4) = acc[ai][bj][m][1] + bv[bj][1]; } } }
    }
};
__device__ __forceinline__ f32x4 gate_safe(f32x4 g) { f32x4 r;
#pragma unroll
    for (int e = 0; e < 4; ++e) r[e] = __builtin_copysignf(fmaxf(fabsf(g[e]), 1e-30f), g[e]);
    return r; }
struct EpiResid { static constexpr bool PERM = false, AFTER_DRAIN = false, HAS_INIT = false;     float* x; const float* gate; float* part; int ntk; float gscale;
    __device__ __forceinline__ void init(f32x4 (&acc)[2][2][4][2], const Unit& u, int wr, int wc, int fr, int fq) const {
        if (u.nt) return;
        const int row0 = u.pm * 256 + wr * 64 + fr, col0 = u.pn * 256 + wc * 32 + 4 * fq;
#pragma unroll
        for (int ai = 0; ai < 2; ++ai)
#pragma unroll
            for (int m = 0; m < 4; ++m) { const int r = row0 + ai * 128 + m * 16; int seq, t; row_info(r, seq, t);
                const float* xr = x + (size_t)r * DM + col0; const float* gr = gate + (size_t)seq * MODW + col0;
#pragma unroll
                for (int bj = 0; bj < 2; ++bj)
#pragma unroll
                    for (int n = 0; n < 2; ++n) { const int o = bj * 128 + 16 * n; const f32x4 xv = *(const f32x4*)(xr + o), gv = gate_safe(*(const f32x4*)(gr + o));
#pragma unroll
                        for (int e = 0; e < 4; ++e) acc[ai][bj][m][n][e] = xv[e] * __builtin_amdgcn_rcpf(gv[e]); } }
    }
    __device__ __forceinline__ void operator()(const f32x4 (&acc)[2][2][4][2], const Unit& u, int wr, int wc, int fr, int fq) const {
        const int row0 = u.pm * 256 + wr * 64 + fr, col0 = u.pn * 256 + wc * 32 + 4 * fq;
        if (u.nt) {
#pragma unroll
            for (int ai = 0; ai < 2; ++ai) { f32x4 gq[4][2][2];
#pragma unroll
                for (int m = 0; m < 4; ++m) { const int r = row0 + ai * 128 + m * 16; int seq, t; row_info(r, seq, t); const float* gr = gate + (size_t)seq * MODW + col0;
#pragma unroll
                    for (int bj = 0; bj < 2; ++bj)
#pragma unroll
                        for (int n = 0; n < 2; ++n) gq[m][bj][n] = *(const f32x4*)(gr + bj * 128 + 16 * n); }
#pragma unroll
                for (int m = 0; m < 4; ++m) { const int r = row0 + ai * 128 + m * 16; float* pr = part + ((size_t)(u.k0 / ntk) * MS + (r - MP)) * DM + col0;
#pragma unroll
                    for (int bj = 0; bj < 2; ++bj)
#pragma unroll
                        for (int n = 0; n < 2; ++n) *(f32x4*)(pr + bj * 128 + 16 * n) = gq[m][bj][n] * gscale * acc[ai][bj][m][n]; }
                asm volatile("" ::: "memory"); }
        } else {
            int seq0, t0; row_info(u.pm * 256, seq0, t0); const float* gr = gate + (size_t)seq0 * MODW + col0;
            f32x4 gv[2][2];
#pragma unroll
            for (int bj = 0; bj < 2; ++bj)
#pragma unroll
                for (int n = 0; n < 2; ++n) gv[bj][n] = *(const f32x4*)(gr + bj * 128 + 16 * n) * gscale;
#pragma unroll
            for (int ai = 0; ai < 2; ++ai) { f32x4 xv[4][2][2];
#pragma unroll
                for (int m = 0; m < 4; ++m)
#pragma unroll
                    for (int bj = 0; bj < 2; ++bj)
#pragma unroll
                        for (int n = 0; n < 2; ++n) xv[m][bj][n] = *(const f32x4*)(x + (size_t)(row0 + ai * 128 + m * 16) * DM + col0 + bj * 128 + 16 * n);
#pragma unroll
                for (int m = 0; m < 4; ++m)
#pragma unroll
                    for (int bj = 0; bj < 2; ++bj)
#pragma unroll
                        for (int n = 0; n < 2; ++n) *(f32x4*)(x + (size_t)(row0 + ai * 128 + m * 16) * DM + col0 + bj * 128 + 16 * n) = xv[m][bj][n] + gv[bj][n] * acc[ai][bj][m][n];
                asm volatile("" ::: "memory"); }
        }
    }
};
__device__ __forceinline__ float gelu_tanh(float x) { const float y = x * (1.0f + 0.044715f * x * x) * (1.5957691216057308f * LOG2E); return x * __builtin_amdgcn_rcpf(1.0f + __builtin_amdgcn_exp2f(-y)); }
struct EpiGelu { static constexpr bool PERM = true, AFTER_DRAIN = false, HAS_INIT = false; bf16_t* U; bf16_t* V; const float* bias; float* rstat;
    __device__ __forceinline__ void operator()(const f32x4 (&acc)[2][2][4][2], const Unit& u, int wr, int wc, int fr, int fq) const {
        const int row0 = u.pm * 256 + wr * 64 + fr, colt = u.pn * 256, col0 = colt + wc * 32 + 8 * fq;
        bf16_t* base = (colt < DSGU ? U : V) + ((col0) & (DSGU - 1));
        f32x4 bv[2][2];
#pragma unroll
        for (int bj = 0; bj < 2; ++bj)
#pragma unroll
            for (int n = 0; n < 2; ++n) bv[bj][n] = *(const f32x4*)(bias + col0 + bj * 128 + 4 * n);
#pragma unroll
        for (int ai = 0; ai < 2; ++ai)
#pragma unroll
            for (int m = 0; m < 4; ++m) { const int r = row0 + ai * 128 + m * 16; float s1 = 0.f, s2 = 0.f;
#pragma unroll
                for (int bj = 0; bj < 2; ++bj) { f32x4 v0 = acc[ai][bj][m][0] + bv[bj][0], v1 = acc[ai][bj][m][1] + bv[bj][1];
#pragma unroll
                    for (int e = 0; e < 4; ++e) { v0[e] = gelu_tanh(v0[e]); v1[e] = gelu_tanh(v1[e]); s1 += v0[e] + v1[e]; s2 += v0[e] * v0[e] + v1[e] * v1[e]; }
                    st16(base + (size_t)r * DSGU + bj * 128, pack8(v0, v1)); }
                if (colt >= DSGU) { s1 += __shfl_xor(s1, 16); s2 += __shfl_xor(s2, 16); s1 += __shfl_xor(s1, 32); s2 += __shfl_xor(s2, 32);
                    if (fq == 0) { unsafeAtomicAdd(rstat + 2 * r, s1); unsafeAtomicAdd(rstat + 2 * r + 1, s2); } } }
    }
};
struct EpiUp { static constexpr bool PERM = true, AFTER_DRAIN = false, HAS_INIT = false; bf16_t* a; float* ocp; float* ocs;
    __device__ __forceinline__ void operator()(const f32x4 (&acc)[2][2][4][2], const Unit& u, int wr, int wc, int fr, int fq) const {
        const int row0 = u.pm * 256 + wr * 64 + fr, col0 = u.pn * 256 + wc * 32 + 8 * fq;
#pragma unroll
        for (int ai = 0; ai < 2; ++ai)
#pragma unroll
            for (int m = 0; m < 4; ++m) { const int r = row0 + ai * 128 + m * 16; int seq, t; row_info(r, seq, t);
                float* tail = nullptr;
                if (r < MP) { if (t >= SEQ - 2) tail = ocp + (size_t)(seq * 2 + (t - (SEQ - 2))) * DFF2; }
                else if (t >= 6) tail = ocs + (size_t)((seq - 2) * 2 + (t - 6)) * DFF2;
#pragma unroll
                for (int bj = 0; bj < 2; ++bj) { const int c = col0 + bj * 128;
                    st16(a + (size_t)r * DFF2 + c, pack8(acc[ai][bj][m][0], acc[ai][bj][m][1]));
                    if (tail) { *(f32x4*)(tail + c) = acc[ai][bj][m][0]; *(f32x4*)(tail + c + 4) = acc[ai][bj][m][1]; } } }
    }
};
struct EpiQKV { static constexpr bool PERM = true, AFTER_DRAIN = false, HAS_INIT = false; bf16_t *Q, *K, *V; const float* bias; const float* rope; float *okp, *ovp, *oks, *ovs;
    __device__ __forceinline__ void operator()(const f32x4 (&acc)[2][2][4][2], const Unit& u, int wr, int wc, int fr, int fq) const {
        const int row0 = u.pm * 256 + wr * 64 + fr, colt = u.pn * 256, col0 = colt + wc * 32 + 8 * fq;
        const int kind = colt < 1024 ? 0 : (colt < 1280 ? 1 : 2);
        const bool do_rope = kind < 2 && (wc & 1) == 0;
        const float sgn = fq == 0 ? -1.f : 1.f;
        f32x4 bv[2][2];
#pragma unroll
        for (int bj = 0; bj < 2; ++bj)
#pragma unroll
            for (int n = 0; n < 2; ++n) bv[bj][n] = *(const f32x4*)(bias + col0 + bj * 128 + 4 * n);
        f32x4 rc0[2], rc1[2], rs0[2], rs1[2];
#pragma unroll
        for (int mm = 0; mm < 2; ++mm) { rc0[mm] = rc1[mm] = (f32x4){1.f, 1.f, 1.f, 1.f}; rs0[mm] = rs1[mm] = (f32x4){0.f, 0.f, 0.f, 0.f}; }
#pragma unroll
        for (int ai = 0; ai < 2; ++ai)
#pragma unroll
            for (int m = 0; m < 4; ++m) { const int r = row0 + ai * 128 + m * 16; int seq, t; row_info(r, seq, t);
                if ((m & 1) == 0 && do_rope && fq < 2) {
#pragma unroll
                    for (int mm = m; mm < m + 2; ++mm) { const int r_ = row0 + ai * 128 + mm * 16; int sq_, t_; row_info(r_, sq_, t_); const float* rp = rope + (size_t)(r_ < MP ? t_ : SEQ + t_) * 16;
                        rc0[mm & 1] = *(const f32x4*)rp; rc1[mm & 1] = *(const f32x4*)(rp + 4); rs0[mm & 1] = *(const f32x4*)(rp + 8) * sgn; rs1[mm & 1] = *(const f32x4*)(rp + 12) * sgn; } }
                const f32x4 c0 = rc0[m & 1], c1 = rc1[m & 1], s0 = rs0[m & 1], s1 = rs1[m & 1];
                float* tk = nullptr;
                if (kind > 0) { float* ob_p = kind == 1 ? okp : ovp; float* ob_s = kind == 1 ? oks : ovs;
                    if (r < MP) { if (t >= SEQ - 128) tk = ob_p + (size_t)(seq * 128 + (t - (SEQ - 128))) * 256; }
                    else tk = ob_s + (size_t)((seq - 2) * 128 + 120 + t) * 256; }
#pragma unroll
                for (int bj = 0; bj < 2; ++bj) { f32x4 v0 = acc[ai][bj][m][0] + bv[bj][0], v1 = acc[ai][bj][m][1] + bv[bj][1];
                    if (do_rope) { f32x4 p0, p1;
#pragma unroll
                        for (int e = 0; e < 4; ++e) { p0[e] = __shfl_xor(v0[e], 16); p1[e] = __shfl_xor(v1[e], 16); }
                        v0 = v0 * c0 + p0 * s0; v1 = v1 * c1 + p1 * s1; }
                    const int cl = (col0 & 255) + bj * 128;
                    if (kind == 0) { v0 = v0 * QSCALE; v1 = v1 * QSCALE; st16(Q + (size_t)r * DM + colt + cl, pack8(v0, v1)); }
                    else { bf16_t* dst = (kind == 1 ? K : V) + (size_t)r * 256 + cl; st16(dst, pack8(v0, v1));
                        if (tk) { *(f32x4*)(tk + cl) = v0; *(f32x4*)(tk + cl + 4) = v1; } } } }
    }
};

struct ResidOrder { pg8::StaticOrder so; int S, ntk;
    __device__ void init(int G, int c, int S_, int ntk_) { so.init(MP, DM, G, c); S = S_; ntk = ntk_; }
    __device__ bool next(int i, Unit& u) const {
        if (so.G == so.nwg) {
            const bool has_split = so.c < 16 * S;
            if (has_split && i == 0) { const int t16 = so.c / S, ks = so.c % S; u.pm = MP / 256 + (t16 >> 2); u.pn = t16 & 3; u.k0 = ks * ntk; u.nt = ntk; return true; }
            if (i == (has_split ? 1 : 0)) return so.next(0, u);
            return false; }
        const long L = (long)i * so.G + so.c;
        if (L < so.nwg) return so.next(i, u);
        const int s = (int)(L - so.nwg); if (s >= 16 * S) return false;
        const int t16 = s / S, ks = s % S; u.pm = MP / 256 + (t16 >> 2); u.pn = t16 & 3; u.k0 = ks * ntk; u.nt = ntk; return true;
    }
    __device__ __forceinline__ void a_ready(const Unit&) const {}
    __device__ __forceinline__ void done(const Unit&) const {}
};
__device__ __forceinline__ unsigned f2bf(float f) { unsigned u = __builtin_bit_cast(unsigned, f); return (u + 0x7fffu + ((u >> 16) & 1u)) >> 16; }
__device__ __forceinline__ unsigned pk2(float lo, float hi) { return f2bf(lo) | (f2bf(hi) << 16); }
struct TItem { const float* src; bf16_t* dst; int K, N; };
__device__ __forceinline__ void titem_load(const TItem& t, f32x4 (&v)[8], int lane) {
#pragma unroll
    for (int i = 0; i < 8; ++i) v[i] = *(const f32x4*)(t.src + (size_t)(4 * i + (lane >> 4)) * t.N + (lane & 15) * 4);
}
__device__ __forceinline__ void titem_store(const TItem& t, const f32x4 (&v)[8], LAS float* scr, int lane) {
#pragma unroll
    for (int i = 0; i < 8; ++i) { LAS float* s = scr + (4 * i + (lane >> 4)) * 65 + (lane & 15) * 4; s[0] = v[i][0]; s[1] = v[i][1]; s[2] = v[i][2]; s[3] = v[i][3]; }
    asm volatile("s_waitcnt lgkmcnt(0)" ::: "memory");
#pragma unroll
    for (int j = 0; j < 4; ++j) { const int id = lane + 64 * j, n = id >> 2, c = id & 3; const LAS float* s = scr + (8 * c) * 65 + n;
        u32x4 o; o.x = pk2(s[0 * 65], s[1 * 65]); o.y = pk2(s[2 * 65], s[3 * 65]); o.z = pk2(s[4 * 65], s[5 * 65]); o.w = pk2(s[6 * 65], s[7 * 65]);
        *(u32x4*)(t.dst + (size_t)n * t.K + 8 * c) = o; }
    asm volatile("s_waitcnt lgkmcnt(0)" ::: "memory");
}
__device__ __forceinline__ void prologue_phase(PPtr P, LAS unsigned char* lds, int gw, int NGW, int lane, int wave) {
    LAS float* scr = (LAS float*)(lds + wave * 16384);
    unsigned char* ws = P->ws;
    constexpr int NMAT = 7;
    const int   mi[NMAT] = {I_WADA, I_WQKV, I_WO, I_WSI, I_WSO, I_WUP, I_WDN};
    const int   mk[NMAT] = {DM, DM, DM, DM, DSGU, DM, DFF};
    const int   mn[NMAT] = {6144, QKVN, DM, 2 * DSGU, DM, DFF2, DM};
    const int   ml[NMAT] = {4, 2, 2, 2, 2, 4, 4};
    const size_t mo[NMAT] = {WS_R1, WS_WQKV, WS_WO, WS_WSI, WS_WSO, WS_WUP, WS_WDN};
    int total = 0;
#pragma unroll
    for (int i = 0; i < NMAT; ++i) total += ml[i] * (mk[i] / 32) * (mn[i] / 64);
#define TITEM_DECODE(it_, T_) do { int r_ = (it_); \
        _Pragma("unroll") for (int i = 0; i < NMAT; ++i) { const int per = (mk[i] / 32) * (mn[i] / 64), cnt = ml[i] * per; \
            if (r_ >= 0 && r_ < cnt) { const int l_ = r_ / per, li_ = r_ % per, nblk = mn[i] / 64, kb = li_ / nblk, nb = li_ % nblk; const size_t mat = (size_t)mk[i] * mn[i]; \
                T_.src = P->in[mi[i]] + (size_t)l_ * mat + (size_t)(32 * kb) * mn[i] + 64 * nb; T_.dst = (bf16_t*)(ws + mo[i]) + (size_t)l_ * mat + (size_t)(64 * nb) * mk[i] + 32 * kb; T_.K = mk[i]; T_.N = mn[i]; r_ = -1; } \
            else if (r_ >= 0) r_ -= cnt; } } while (0)
    for (int it = gw; it < total; it += 2 * NGW) {
        TItem ta, tb; f32x4 va[8], vb[8]; const bool two = it + NGW < total;
        TITEM_DECODE(it, ta); titem_load(ta, va, lane);
        if (two) { TITEM_DECODE(it + NGW, tb); titem_load(tb, vb, lane); }
        titem_store(ta, va, scr, lane);
        if (two) titem_store(tb, vb, scr, lane);
    }
#undef TITEM_DECODE
    const int gt = gw * 64 + lane, NGT = NGW * 64;
    float* rope = (float*)(ws + WS_ROPE);
    for (int i = gt; i < NPOS * 8; i += NGT) { const int pos = i >> 3, k = i & 7; const double rev = (double)pos * P->inv[k] * 0.15915494309189535; const float fr = (float)(rev - floor(rev));
        rope[pos * 16 + k] = __builtin_amdgcn_cosf(fr); rope[pos * 16 + 8 + k] = __builtin_amdgcn_sinf(fr); }
    float* rst = (float*)(ws + WS_RSTAT);
    for (int i = gt; i < 2 * M * 2; i += NGT) rst[i] = 0.f;
    bf16_t* wtri = (bf16_t*)(ws + WS_WTRI);
    for (int i = gt; i < 2 * 4 * 2 * 16384; i += NGT) { const int s = i & 127, t = (i >> 7) & 127, var = (i >> 14) & 1, lg = i >> 15; const float* w = P->in[I_WSP] + (size_t)lg * 16384; float v;
        if (var == 0) v = s <= t ? w[t * 128 + s] : 0.f; else v = ((s >> 3) == (t >> 3) && (s & 7) <= (t & 7)) ? w[(t & 7) * 128 + (s & 7)] : 0.f;
        wtri[i] = (bf16_t)f2bf(v); }
    bf16_t* SC = (bf16_t*)(ws + WS_SC);
    for (int i = gt; i < 256 * DM; i += NGT) { const int s = i >> 10, k = i & 1023; float v = 0.f;
        if (s < NSEQ) { const float c = s < 2 ? P->in[I_CP][s * DM + k] : P->in[I_CS][(s - 2) * DM + k]; v = c / (1.0f + __expf(-c)); }
        SC[i] = (bf16_t)f2bf(v); }
}
__device__ __forceinline__ void norm_phase(PPtr P, int l, int mode, bool first, int nsplit, int gw, int NGW, int lane) {
    float* xbuf = P->out; bf16_t* XN = (bf16_t*)(P->ws + WS_R2); const float* mod = (const float*)(P->ws + WS_MOD);
    const float* gw_ = mode == 2 ? P->in[I_NFIN] : (mode == 0 ? P->in[I_NMIX] : P->in[I_NFFN]) + l * DM;
    f32x4 g[4];
#pragma unroll
    for (int j = 0; j < 4; ++j) g[j] = ((const f32x4*)gw_)[lane + 64 * j];
    for (int r = MP + gw; r < M; r += NGW) {
        const float* src = first ? P->in[I_XS] + (size_t)(r - MP) * DM : xbuf + (size_t)r * DM;
        f32x4 v[4], shs[4], scs[4];
#pragma unroll
        for (int j = 0; j < 4; ++j) v[j] = ((const f32x4*)src)[lane + 64 * j];
        if (mode != 2) { int seq, t; row_info(r, seq, t); const float* mr = mod + (size_t)seq * MODW + l * 6144 + (mode ? 3 * DM : 0);
#pragma unroll
            for (int j = 0; j < 4; ++j) { shs[j] = ((const f32x4*)mr)[lane + 64 * j]; scs[j] = ((const f32x4*)(mr + DM))[lane + 64 * j]; } }
        if (nsplit > 0) { const float* pp = (const float*)(P->ws + WS_PART) + (size_t)(r - MP) * DM;
#pragma unroll
            for (int bt = 0; bt < 4; ++bt) { f32x4 pv[3][4];
#pragma unroll
                for (int s = 0; s < 3; ++s) if (bt * 3 + s < nsplit) {
#pragma unroll
                    for (int j = 0; j < 4; ++j) pv[s][j] = ((const f32x4*)(pp + (size_t)(bt * 3 + s) * MS * DM))[lane + 64 * j]; }
#pragma unroll
                for (int s = 0; s < 3; ++s) if (bt * 3 + s < nsplit) {
#pragma unroll
                    for (int j = 0; j < 4; ++j) v[j] += pv[s][j]; }
                asm volatile("" ::: "memory"); } }
        float ss = 0.f;
#pragma unroll
        for (int j = 0; j < 4; ++j) ss += (v[j][0] * v[j][0] + v[j][1] * v[j][1]) + (v[j][2] * v[j][2] + v[j][3] * v[j][3]);
        const float rs = 1.0f / sqrtf(wave_sum(ss) * (1.0f / DM) + EPS);
        if (mode == 2) {
#pragma unroll
            for (int j = 0; j < 4; ++j) ((f32x4*)(xbuf + (size_t)r * DM))[lane + 64 * j] = v[j] * rs * g[j];
        } else {
#pragma unroll
            for (int j = 0; j < 4; ++j) { const f32x4 sh = shs[j], sc = scs[j];
                const f32x4 h = v[j] * rs * g[j] * (sc + 1.0f) + sh; u32x2 w; w.x = cvt_pk_bf16(h[0], h[1]); w.y = cvt_pk_bf16(h[2], h[3]);
                st8((u32x2*)(XN + (size_t)r * DM) + lane + 64 * j, w);
                if (first || nsplit > 0) ((f32x4*)(xbuf + (size_t)r * DM))[lane + 64 * j] = v[j]; } }
    }
    for (int r0 = gw; r0 < MP; r0 += 2 * NGW) {
        const int r1 = r0 + NGW; const bool has1 = r1 < MP;
        f32x4 v[2][4], sh[2][4], sc[2][4];
#pragma unroll
        for (int q = 0; q < 2; ++q) { const int r = q ? r1 : r0; if (q == 0 || has1) {
            const float* src = first ? P->in[I_XP] + (size_t)r * DM : xbuf + (size_t)r * DM;
#pragma unroll
            for (int j = 0; j < 4; ++j) v[q][j] = ((const f32x4*)src)[lane + 64 * j];
            if (mode != 2) { const float* mr = mod + (size_t)(r >> 13) * MODW + l * 6144 + (mode ? 3 * DM : 0);
#pragma unroll
                for (int j = 0; j < 4; ++j) { sh[q][j] = ((const f32x4*)mr)[lane + 64 * j]; sc[q][j] = ((const f32x4*)(mr + DM))[lane + 64 * j]; } } } }
        float ss[2] = {0.f, 0.f};
#pragma unroll
        for (int q = 0; q < 2; ++q) if (q == 0 || has1) {
#pragma unroll
            for (int j = 0; j < 4; ++j) ss[q] += (v[q][j][0] * v[q][j][0] + v[q][j][1] * v[q][j][1]) + (v[q][j][2] * v[q][j][2] + v[q][j][3] * v[q][j][3]); }
        ss[0] = wave_sum(ss[0]); if (has1) ss[1] = wave_sum(ss[1]);
#pragma unroll
        for (int q = 0; q < 2; ++q) { const int r = q ? r1 : r0; if (q == 0 || has1) {
            const float rs = 1.0f / sqrtf(ss[q] * (1.0f / DM) + EPS);
            if (mode == 2) {
#pragma unroll
                for (int j = 0; j < 4; ++j) ((f32x4*)(xbuf + (size_t)r * DM))[lane + 64 * j] = v[q][j] * rs * g[j];
            } else {
#pragma unroll
                for (int j = 0; j < 4; ++j) { const f32x4 h = v[q][j] * rs * g[j] * (sc[q][j] + 1.0f) + sh[q][j]; u32x2 w; w.x = cvt_pk_bf16(h[0], h[1]); w.y = cvt_pk_bf16(h[2], h[3]);
                    st8((u32x2*)(XN + (size_t)r * DM) + lane + 64 * j, w);
                    if (first) ((f32x4*)(xbuf + (size_t)r * DM))[lane + 64 * j] = v[q][j]; }
            } } }
    }
}
__device__ __forceinline__ void ld8bf(const bf16_t* p, f32x4& lo, f32x4& hi) { const u32x4 w = *(const u32x4*)p; lo = (f32x4){bf2f(w.x & 0xffffu), bf2f(w.x >> 16), bf2f(w.y & 0xffffu), bf2f(w.y >> 16)}; hi = (f32x4){bf2f(w.z & 0xffffu), bf2f(w.z >> 16), bf2f(w.w & 0xffffu), bf2f(w.w >> 16)}; }
__device__ __forceinline__ void conv_phase(PPtr P, int l, int gtid, int NGT) {
    const bf16_t* A = (const bf16_t*)(P->ws + WS_R1); bf16_t* HB = (bf16_t*)(P->ws + WS_R2);
    const float* cw = P->in[I_CW] + (size_t)l * 3 * DFF2; const float* cb = P->in[I_CB] + (size_t)l * DFF2; const float* st = P->in[I_SCONV] + (size_t)l * 128 * 2 * DFF2;
    constexpr int NCG = DFF / 8, NITEM = (M / 16) * NCG;
    for (int it = gtid; it < NITEM; it += NGT) {
        const int seg = it / NCG, c = (it % NCG) * 8, r0 = seg * 16; const bool samp = r0 >= MP;
        f32x4 wg[3][2], wu[3][2], bg[2], bu[2];
#pragma unroll
        for (int h = 0; h < 2; ++h) {
#pragma unroll
            for (int j = 0; j < 3; ++j) { wg[j][h] = *(const f32x4*)(cw + j * DFF2 + c + 4 * h); wu[j][h] = *(const f32x4*)(cw + j * DFF2 + DFF + c + 4 * h); }
            bg[h] = *(const f32x4*)(cb + c + 4 * h); bu[h] = *(const f32x4*)(cb + DFF + c + 4 * h); }
        f32x4 g0[2], g1[2], u0[2], u1[2];
        if (!samp) {
            if ((r0 & (SEQ - 1)) == 0) {
#pragma unroll
                for (int h = 0; h < 2; ++h) g0[h] = g1[h] = u0[h] = u1[h] = (f32x4){0.f, 0.f, 0.f, 0.f};
            } else { ld8bf(A + (size_t)(r0 - 2) * DFF2 + c, g0[0], g0[1]); ld8bf(A + (size_t)(r0 - 2) * DFF2 + DFF + c, u0[0], u0[1]); ld8bf(A + (size_t)(r0 - 1) * DFF2 + c, g1[0], g1[1]); ld8bf(A + (size_t)(r0 - 1) * DFF2 + DFF + c, u1[0], u1[1]); }
        }
#pragma unroll
        for (int hb_ = 0; hb_ < 2; ++hb_) {
            u32x4 rg[8], ru[8];
#pragma unroll
            for (int i = 0; i < 8; ++i) { rg[i] = *(const u32x4*)(A + (size_t)(r0 + hb_ * 8 + i) * DFF2 + c); ru[i] = *(const u32x4*)(A + (size_t)(r0 + hb_ * 8 + i) * DFF2 + DFF + c); }
            if (samp) { const float* s = st + (size_t)((r0 - MP + hb_ * 8) >> 3) * 2 * DFF2 + c;
#pragma unroll
                for (int h = 0; h < 2; ++h) { g0[h] = *(const f32x4*)(s + 4 * h); u0[h] = *(const f32x4*)(s + DFF + 4 * h); g1[h] = *(const f32x4*)(s + DFF2 + 4 * h); u1[h] = *(const f32x4*)(s + DFF2 + DFF + 4 * h); } }
#pragma unroll
            for (int i = 0; i < 8; ++i) { f32x4 g2[2], u2[2], hh[2];
                g2[0] = (f32x4){bf2f(rg[i].x & 0xffffu), bf2f(rg[i].x >> 16), bf2f(rg[i].y & 0xffffu), bf2f(rg[i].y >> 16)}; g2[1] = (f32x4){bf2f(rg[i].z & 0xffffu), bf2f(rg[i].z >> 16), bf2f(rg[i].w & 0xffffu), bf2f(rg[i].w >> 16)};
                u2[0] = (f32x4){bf2f(ru[i].x & 0xffffu), bf2f(ru[i].x >> 16), bf2f(ru[i].y & 0xffffu), bf2f(ru[i].y >> 16)}; u2[1] = (f32x4){bf2f(ru[i].z & 0xffffu), bf2f(ru[i].z >> 16), bf2f(ru[i].w & 0xffffu), bf2f(ru[i].w >> 16)};
#pragma unroll
                for (int h = 0; h < 2; ++h) { const f32x4 cg_ = wg[0][h] * g0[h] + wg[1][h] * g1[h] + wg[2][h] * g2[h] + bg[h], cu = wu[0][h] * u0[h] + wu[1][h] * u1[h] + wu[2][h] * u2[h] + bu[h];
#pragma unroll
                    for (int e = 0; e < 4; ++e) hh[h][e] = cg_[e] * __builtin_amdgcn_rcpf(1.0f + __builtin_amdgcn_exp2f(-cg_[e] * LOG2E)) * cu[e];
                    g0[h] = g1[h]; g1[h] = g2[h]; u0[h] = u1[h]; u1[h] = u2[h]; }
                st16(HB + (size_t)(r0 + hb_ * 8 + i) * DFF + c, pack8(hh[0], hh[1])); }
        }
    }
}

constexpr int KPITCH = 144  , VPITCH = 544  , ATT_K = 0, ATT_V = 256 * KPITCH;
typedef unsigned long long u64;
__device__ __forceinline__ void attn16(const LAS unsigned char* Kl, const LAS unsigned char* Vt, const bf16x8 (&qf)[2], bf16_t* optr, int qi, int jmin, float sink2, int kw0, int fr, int fq) {
    f32x4 s[10];
#pragma unroll
    for (int kt = 0; kt < 10; ++kt) { s[kt] = (f32x4){0.f, 0.f, 0.f, 0.f};
#pragma unroll
        for (int kk = 0; kk < 2; ++kk) { const bf16x8 kf = *(const LAS bf16x8*)(Kl + (kw0 + 16 * kt + fr) * KPITCH + (32 * kk + 8 * fq) * 2); s[kt] = __builtin_amdgcn_mfma_f32_16x16x32_bf16(kf, qf[kk], s[kt], 0, 0, 0); } }
    const int lo = qi > jmin ? qi : jmin, hi = qi + 128; float mx = sink2;
#pragma unroll
    for (int kt = 0; kt < 10; ++kt)
#pragma unroll
        for (int i = 0; i < 4; ++i) { const int j = kw0 + 16 * kt + 4 * fq + i; const float v = (j >= lo && j <= hi) ? s[kt][i] : -INFINITY; s[kt][i] = v; mx = fmaxf(mx, v); }
    mx = fmaxf(mx, __shfl_xor(mx, 16)); mx = fmaxf(mx, __shfl_xor(mx, 32));
    float sum = 0.f;
#pragma unroll
    for (int kt = 0; kt < 10; ++kt)
#pragma unroll
        for (int i = 0; i < 4; ++i) { const float p = __builtin_amdgcn_exp2f(s[kt][i] - mx); s[kt][i] = p; sum += p; }
    sum += __shfl_xor(sum, 16); sum += __shfl_xor(sum, 32); sum += __builtin_amdgcn_exp2f(sink2 - mx);
    const float inv = 1.0f / sum;
    f32x4 o[4];
#pragma unroll
    for (int dt = 0; dt < 4; ++dt) o[dt] = (f32x4){0.f, 0.f, 0.f, 0.f};
#pragma unroll
    for (int sl = 0; sl < 5; ++sl) { const u32x4 pw = pack8(s[2 * sl], s[2 * sl + 1]); const bf16x8 pf = __builtin_bit_cast(bf16x8, pw);
#pragma unroll
        for (int dt = 0; dt < 4; ++dt) { const LAS unsigned char* vp = Vt + (dt * 16 + fr) * VPITCH + (kw0 + 32 * sl + 4 * fq) * 2;
            const u32x2 a = *(const LAS u32x2*)vp, b = *(const LAS u32x2*)(vp + 32); const u32x4 vw = {a.x, a.y, b.x, b.y};
            o[dt] = __builtin_amdgcn_mfma_f32_16x16x32_bf16(__builtin_bit_cast(bf16x8, vw), pf, o[dt], 0, 0, 0); } }
#pragma unroll
    for (int dt = 0; dt < 4; ++dt) { u32x2 w; w.x = cvt_pk_bf16(o[dt][0] * inv, o[dt][1] * inv); w.y = cvt_pk_bf16(o[dt][2] * inv, o[dt][3] * inv); *(u32x2*)(optr + dt * 16 + 4 * fq) = w; }
}
__device__ __forceinline__ void attn_phase(PPtr P, int la, LAS unsigned char* lds, int vcu, int G, int tid, int wave, int lane) {
    const bf16_t* Q = (const bf16_t*)(P->ws + WS_R1); const bf16_t* K = (const bf16_t*)(P->ws + WS_R1 + 34 * MiB); const bf16_t* V = (const bf16_t*)(P->ws + WS_R1 + 43 * MiB); bf16_t* O = (bf16_t*)(P->ws + WS_R1 + 52 * MiB);
    const float* sink = P->in[I_SINK] + la * 16; const int fr = lane & 15, fq = lane >> 4;
    LAS unsigned char* Kl = lds + ATT_K; LAS unsigned char* Vt = lds + ATT_V;
    const float* ck = P->in[I_CK] + (size_t)la * 128 * 128 * 256; const float* cv = P->in[I_CV] + (size_t)la * 128 * 128 * 256;
    float* oks = P->out + O_KS + (size_t)la * 128 * 128 * 256; float* ovs = P->out + O_VS + (size_t)la * 128 * 128 * 256;
#define VT_SCATTER(part_, j_, vv_) do { _Pragma("unroll") for (int e = 0; e < 4; ++e) { *(LAS unsigned short*)(Vt + ((part_) * 8 + 2 * e) * VPITCH + (j_) * 2) = (unsigned short)((vv_)[e] & 0xffffu); *(LAS unsigned short*)(Vt + ((part_) * 8 + 2 * e + 1) * VPITCH + (j_) * 2) = (unsigned short)((vv_)[e] >> 16); } } while (0)
    for (int un = vcu; un < 1024; un += G) {
        if (un < 512) {
            const int b = un >> 8, g = (un >> 6) & 3, qb = un & 63; const int rbase = b * SEQ + qb * 128;
            const int qi = 16 * wave + fr, kw0 = wave < 6 ? 16 * wave : 96, jmin = qb == 0 ? 128 : 0;
            const bf16_t* qrow = Q + (size_t)(rbase + qi) * DM + 4 * g * 64 + 8 * fq;
            bf16x8 qf[2], qn[2];
#pragma unroll
            for (int kk = 0; kk < 2; ++kk) qf[kk] = *(const bf16x8*)(qrow + 32 * kk);
            const f32x4 snk = *(const f32x4*)(sink + 4 * g) * LOG2E;
            u32x4 kv[4], vv[4];
#pragma unroll
            for (int k = 0; k < 4; ++k) { const int ci = tid + 512 * k, j = ci >> 3, part = ci & 7; int row = rbase - 128 + j; if (qb == 0 && j < 128) row = rbase + j;
                kv[k] = *(const u32x4*)(K + (size_t)row * 256 + g * 64 + part * 8); vv[k] = *(const u32x4*)(V + (size_t)row * 256 + g * 64 + part * 8); }
#pragma unroll
            for (int k = 0; k < 4; ++k) { const int ci = tid + 512 * k, j = ci >> 3, part = ci & 7; *(LAS u32x4*)(Kl + j * KPITCH + part * 16) = kv[k]; VT_SCATTER(part, j, vv[k]); }
            __syncthreads();
#pragma unroll
            for (int hh = 0; hh < 4; ++hh) { const int h = 4 * g + hh;
                if (hh < 3) {
#pragma unroll
                    for (int kk = 0; kk < 2; ++kk) qn[kk] = *(const bf16x8*)(qrow + (hh + 1) * 64 + 32 * kk); }
                attn16(Kl, Vt, qf, O + (size_t)(rbase + qi) * DM + h * 64, qi, jmin, snk[hh], kw0, fr, fq);
                qf[0] = qn[0]; qf[1] = qn[1]; }
        } else {
            const int b = (un - 512) >> 2, g = un & 3;
            const int hs = 4 * g + 2 * (wave & 1) + (fr >> 3), ts = fr & 7; const size_t ros = (size_t)(MP + b * 8 + ts) * DM + hs * 64;
            bf16x8 qf[2];
#pragma unroll
            for (int kk = 0; kk < 2; ++kk) qf[kk] = *(const bf16x8*)(Q + ros + 32 * kk + 8 * fq);
            const float snk = sink[hs] * LOG2E;
            f32x4 ck0[2], ck1[2], cv0[2], cv1[2]; u32x4 nk = {0u, 0u, 0u, 0u}, nv = nk;
#pragma unroll
            for (int it = 0; it < 2; ++it) { const int ci = tid + 512 * it, j = ci >> 3, part = ci & 7; const size_t so = ((size_t)(b * 128 + j) * 4 + g) * 64 + part * 8;
                ck0[it] = *(const f32x4*)(ck + so); ck1[it] = *(const f32x4*)(ck + so + 4); cv0[it] = *(const f32x4*)(cv + so); cv1[it] = *(const f32x4*)(cv + so + 4); }
            { const int j = 128 + (tid >> 3), part = tid & 7; if (tid < 256 && j < 136) { const size_t row = MP + b * 8 + (j - 128); nk = *(const u32x4*)(K + row * 256 + g * 64 + part * 8); nv = *(const u32x4*)(V + row * 256 + g * 64 + part * 8); } }
#pragma unroll
            for (int it = 0; it < 2; ++it) { const int ci = tid + 512 * it, j = ci >> 3, part = ci & 7;
                if (j >= 8) { const size_t d = ((size_t)(b * 128 + j - 8) * 4 + g) * 64 + part * 8; *(f32x4*)(oks + d) = ck0[it]; *(f32x4*)(oks + d + 4) = ck1[it]; *(f32x4*)(ovs + d) = cv0[it]; *(f32x4*)(ovs + d + 4) = cv1[it]; }
                *(LAS u32x4*)(Kl + j * KPITCH + part * 16) = pack8(ck0[it], ck1[it]); const u32x4 vvp = pack8(cv0[it], cv1[it]); VT_SCATTER(part, j, vvp); }
            if (tid < 256) { const int j = 128 + (tid >> 3), part = tid & 7; *(LAS u32x4*)(Kl + j * KPITCH + part * 16) = nk; VT_SCATTER(part, j, nv); }
            __syncthreads();
            if (wave < 2) attn16(Kl, Vt, qf, O + ros, ts, 0, snk, 0, fr, fq);
        }
        __syncthreads();
    }
#undef VT_SCATTER
}

constexpr int WPITCH = 272  , MIX_W = 0, MIX_V = 128 * WPITCH;
__device__ __forceinline__ void mix_phase(PPtr P, int ls, LAS unsigned char* lds, int vcu, int G, int tid, int wave, int lane, bool dummy) {
    bf16_t* U = (bf16_t*)(P->ws + WS_R1); const bf16_t* VR = (const bf16_t*)(P->ws + WS_R1 + (size_t)M * DSGU * 2);
    const float* rstat = (const float*)(P->ws + WS_RSTAT) + (size_t)ls * M * 2; const bf16_t* wtri = (const bf16_t*)(P->ws + WS_WTRI) + (size_t)ls * 4 * 2 * 16384;
    const float* lg = P->in[I_LNG] + ls * DSGU; const float* lb = P->in[I_LNB] + ls * DSGU; float* osg = P->out + O_SG + (size_t)ls * MS * DSGU;
    const float* bsp = P->in[I_BSP] + ls * 4 * 128; const int fr = lane & 15, fq = lane >> 4;
    LAS unsigned char* Wl = lds + MIX_W; LAS unsigned char* Vb = lds + MIX_V;
    constexpr int VBUF = 128 * WPITCH, NUN = 136 * 16;
    const int part = tid & 15, sb = tid >> 4;
#define LDS_BAR() do { asm volatile("s_waitcnt lgkmcnt(0)" ::: "memory"); __builtin_amdgcn_s_barrier(); asm volatile("" ::: "memory"); } while (0)
    u32x4 raw[4]; float st0[4], st1[4]; int wvar = -1;
#define MIX_LOAD(un_) do { const int rc_ = (un_) >> 4, colb_ = (((un_) >> 2) & 3) * 512 + ((un_) & 3) * 128 + part * 8; \
        _Pragma("unroll") for (int k = 0; k < 4; ++k) { const int row_ = rc_ * 128 + sb + 32 * k; raw[k] = *(const u32x4*)(VR + (size_t)row_ * DSGU + colb_); st0[k] = rstat[2 * row_]; st1[k] = rstat[2 * row_ + 1]; } } while (0)
#define MIX_FILL(un_, Vl_) do { const int rc_ = (un_) >> 4, c0 = (((un_) >> 2) & 3) * 512 + ((un_) & 3) * 128 + part * 8; const bool samp_ = rc_ >= 128; \
        const f32x4 g0 = *(const f32x4*)(lg + c0), g1 = *(const f32x4*)(lg + c0 + 4), b0 = *(const f32x4*)(lb + c0), b1 = *(const f32x4*)(lb + c0 + 4); \
        _Pragma("unroll") for (int k = 0; k < 4; ++k) { const int s = sb + 32 * k, row = rc_ * 128 + s; const u32x4 w = raw[k]; \
            const f32x4 x0 = {bf2f(w.x & 0xffffu), bf2f(w.x >> 16), bf2f(w.y & 0xffffu), bf2f(w.y >> 16)}, x1 = {bf2f(w.z & 0xffffu), bf2f(w.z >> 16), bf2f(w.w & 0xffffu), bf2f(w.w >> 16)}; \
            const float mu = st0[k] * (1.0f / DSGU), var_ = fmaxf(st1[k] * (1.0f / DSGU) - mu * mu, 0.f), rs = 1.0f / sqrtf(var_ + EPS); \
            const f32x4 y0 = (x0 - mu) * rs * g0 + b0, y1 = (x1 - mu) * rs * g1 + b1; \
            if (samp_) { float* o = osg + (size_t)(row - MP) * DSGU + c0; *(f32x4*)o = y0; *(f32x4*)(o + 4) = y1; } \
            const u32x4 vv = pack8(y0, y1); const int so = ((((s >> 3) ^ part) << 3) + (s & 7)) * 2; \
            _Pragma("unroll") for (int e = 0; e < 4; ++e) { *(LAS unsigned short*)((Vl_) + (part * 8 + 2 * e) * WPITCH + so) = (unsigned short)(vv[e] & 0xffffu); *(LAS unsigned short*)((Vl_) + (part * 8 + 2 * e + 1) * WPITCH + so) = (unsigned short)(vv[e] >> 16); } } } while (0)
    int un = vcu, cur = 0;
    if (un < NUN) { MIX_LOAD(un); MIX_FILL(un, Vb); if (un + G < NUN) MIX_LOAD(un + G); }
    LDS_BAR();
    for (; un < NUN; un += G, cur ^= 1) {
        const int rc = un >> 4, g = (un >> 2) & 3, cs = un & 3; const bool samp = rc >= 128; const int colb = g * 512 + cs * 128;
        LAS unsigned char* Vl = Vb + cur * VBUF;
        const int var = g * 2 + (samp ? 1 : 0);
        if (var != wvar) { wvar = var; const bf16_t* wt = wtri + (size_t)var * 16384;
#pragma unroll
            for (int k = 0; k < 4; ++k) { const int ci = tid + 512 * k, t = ci >> 4, q = ci & 15; *(LAS u32x4*)(Wl + t * WPITCH + q * 16) = *(const u32x4*)(wt + t * 128 + q * 8); }
            LDS_BAR(); }
        u32x2 uws[8]; float bss[8];
#pragma unroll
        for (int tt = 0; tt < 8; ++tt) { const int t = tt * 16 + fr; uws[tt] = *(const u32x2*)(U + (size_t)(rc * 128 + t) * DSGU + colb + wave * 16 + 4 * fq); bss[tt] = bsp[g * 128 + (samp ? (t & 7) : t)]; }
        if (un + G < NUN) { MIX_FILL(un + G, Vb + (cur ^ 1) * VBUF); if (un + 2 * G < NUN) MIX_LOAD(un + 2 * G); }
        bf16x8 vf[4];
#pragma unroll
        for (int ks = 0; ks < 4; ++ks) vf[ks] = *(const LAS bf16x8*)(Vl + (wave * 16 + fr) * WPITCH + (((4 * ks + fq) ^ (wave * 2 + (fr >> 3))) << 4));
#pragma unroll
        for (int tt = 0; tt < 8; ++tt) { f32x4 acc = {0.f, 0.f, 0.f, 0.f};
#pragma unroll
            for (int ks = 0; ks < 4; ++ks) if (ks <= tt / 2) { const bf16x8 wf = *(const LAS bf16x8*)(Wl + (tt * 16 + fr) * WPITCH + (32 * ks + 8 * fq) * 2); acc = __builtin_amdgcn_mfma_f32_16x16x32_bf16(vf[ks], wf, acc, 0, 0, 0); }
            const int t = tt * 16 + fr; const float bias = bss[tt];
            bf16_t* up = U + (size_t)(rc * 128 + t) * DSGU + colb + wave * 16 + 4 * fq; const u32x2 uw = uws[tt];
            u32x2 w; w.x = cvt_pk_bf16(bf2f(uw.x & 0xffffu) * (acc[0] + bias), bf2f(uw.x >> 16) * (acc[1] + bias)); w.y = cvt_pk_bf16(bf2f(uw.y & 0xffffu) * (acc[2] + bias), bf2f(uw.y >> 16) * (acc[3] + bias));
            *(u32x2*)(dummy ? up + (size_t)68 * MiB : up) = w; }
        LDS_BAR();
    }
#undef MIX_LOAD
#undef MIX_FILL
#undef LDS_BAR
}

#define XB_TMO      128
#define XB_XCNT(j)  (256  + 64 * (j))
#define XB_XSUB(j)  (1280 + 64 * (j))
#define XB_XGEN(j)  (2304 + 64 * (j))
#define XB_TOP      3328
#define XB_TOPGEN   3392
#define XCD_BAR_WORDS 3456
#define XB_SPIN_CAP (1u << 18)

__device__ __forceinline__ unsigned xb_ld(unsigned* p)              { return __hip_atomic_load(p, __ATOMIC_RELAXED, __HIP_MEMORY_SCOPE_AGENT); }
__device__ __forceinline__ unsigned xb_add(unsigned* p, unsigned v) { return __hip_atomic_fetch_add(p, v, __ATOMIC_RELAXED, __HIP_MEMORY_SCOPE_AGENT); }
__device__ __forceinline__ unsigned xb_xcc_id() { return (unsigned)__builtin_amdgcn_s_getreg((3 << 11) | 20) & 0xFu; }
#define XB_SPIN(cond, bar) do { unsigned _sp = 0; while (cond) { __builtin_amdgcn_s_sleep(1); \
    if ((++_sp & 255u) == 0u) { if (xb_ld(&(bar)[XB_TMO])) break; if (_sp > XB_SPIN_CAP) { atomicAdd(&(bar)[XB_TMO], 1u); break; } } } } while (0)

struct XcdBarrier {
    unsigned* bar; unsigned x;
    volatile LAS unsigned* st;
};

__device__ __forceinline__ XcdBarrier xcd_barrier_post(unsigned* bar, volatile LAS unsigned* st) {
    XcdBarrier b; b.bar = bar; b.x = xb_xcc_id(); b.st = st;
    if (threadIdx.x == 0) (void)xb_add(&bar[XB_XCNT(b.x)], 1u);
    return b;
}
__device__ __forceinline__ void xcd_barrier_complete(unsigned* bar, unsigned x, unsigned& nloc, unsigned& nx) {
    const unsigned G = gridDim.x * gridDim.y * gridDim.z;
    unsigned sum, cnt, mine, sp = 0u;
    for (;;) {
        sum = 0u; cnt = 0u; mine = 0u;
#pragma unroll
        for (unsigned j = 0; j < 16; ++j) { const unsigned c = xb_ld(&bar[XB_XCNT(j)]); sum += c; cnt += (c > 0u) ? 1u : 0u; mine = (j == x) ? c : mine; }
        if (sum == G) break;
        __builtin_amdgcn_s_sleep(1);
        if ((++sp & 255u) == 0u) { if (xb_ld(&bar[XB_TMO])) break; if (sp > XB_SPIN_CAP) { atomicAdd(&bar[XB_TMO], 1u); break; } }
    }
    nloc = mine > 0u ? mine : 1u; nx = cnt > 0u ? cnt : 1u;
}

__device__ __forceinline__ void xcd_barrier(const XcdBarrier& b) {
    asm volatile("s_waitcnt vmcnt(0)" ::: "memory");
    __syncthreads();
    if (threadIdx.x == 0) {
        unsigned* bar = b.bar;
        __builtin_amdgcn_s_waitcnt(0);
        unsigned nloc = b.st[0], nx = b.st[1];
        if (nloc == 0u) { xcd_barrier_complete(bar, b.x, nloc, nx); b.st[0] = nloc; b.st[1] = nx; }
        const unsigned old = xb_add(&bar[XB_XSUB(b.x)], 1u);
        const unsigned gen = old / nloc;
        if (old + 1u == (gen + 1u) * nloc) {
            __builtin_amdgcn_fence(__ATOMIC_RELEASE, "agent");
            asm volatile("s_waitcnt vmcnt(0)" ::: "memory");
            const unsigned og = xb_add(&bar[XB_TOP], 1u);
            const unsigned tg = og / nx;
            if (og + 1u == (tg + 1u) * nx) xb_add(&bar[XB_TOPGEN], 1u);
            else XB_SPIN(xb_ld(&bar[XB_TOPGEN]) == tg, bar);
            __builtin_amdgcn_fence(__ATOMIC_ACQUIRE, "agent");
            xb_add(&bar[XB_XGEN(b.x)], 1u);
            asm volatile("s_waitcnt vmcnt(0)" ::: "memory");
        } else {
            XB_SPIN(xb_ld(&bar[XB_XGEN(b.x)]) == gen, bar);
            __builtin_amdgcn_fence(__ATOMIC_ACQUIRE, "agent");
            asm volatile("s_waitcnt vmcnt(0)" ::: "memory");
        }
    }
    __syncthreads();
}

#ifndef DBG_REP_KIND
#define DBG_REP_KIND -1
#endif
#ifndef DBG_REP_N
#define DBG_REP_N 1
#endif
#ifndef DBG_SYNC_N
#define DBG_SYNC_N 1
#endif
#ifndef DBG_MASK
#define DBG_MASK 0xffff
#endif
#define DM_(k) ((DBG_MASK >> (k)) & 1)
constexpr int N_PHASES = 39;
__device__ __forceinline__ bool phase_active(int ph) { if (ph < 2 || ph == 38) return true; const int l = (ph - 2) / 9, k = (ph - 2) % 9; return !(((l & 1) == 0 && k == 3) || ((l & 1) == 1 && k == 2)); }
__global__ void __launch_bounds__(NTHR) fwd_kernel(Params Pval) {
    PPtr P = (PPtr)__builtin_amdgcn_kernarg_segment_ptr();
    extern __shared__ __attribute__((aligned(16))) unsigned char lds_raw[];
    LAS unsigned char* lds = (LAS unsigned char*)lds_raw;
    { int t0 = threadIdx.x; for (int u = t0; u < (LDS_BYTES - 131072) / 4; u += NTHR) ((LAS unsigned*)(lds + 131072))[u] = 0u; }
    __syncthreads();
    const XcdBarrier xbar = xcd_barrier_post((unsigned*)P->ws + 4096, (volatile LAS unsigned*)(lds + 131072 + 320) + 8);
    const int ph_hi = P->ph_hi;
    for (int it = P->ph_lo * DBG_REP_N; it < ph_hi * DBG_REP_N; ++it) {
        const int ph = it / DBG_REP_N;
        if (!phase_active(ph)) continue;
        asm volatile("" : "+s"(P));
        int tid = threadIdx.x; asm volatile("" : "+v"(tid)); const int lane = tid & 63, wave = __builtin_amdgcn_readfirstlane(tid >> 6);
        int G = gridDim.x, bx = blockIdx.x; asm volatile("" : "+s"(G), "+s"(bx)); const int vcu = (G % 8 == 0) ? (bx % 8) * (G / 8) + bx / 8 : bx;
        unsigned char* ws = P->ws; float* mod = (float*)(ws + WS_MOD); const bf16_t* XN = (const bf16_t*)(ws + WS_R2);
        const int gw = vcu * NWAVES + wave, NGW = G * NWAVES;
        int kind, l = 0, li = 0, k = 0;
        if (ph == 0) kind = 0; else if (ph == 1) kind = 1; else if (ph == 38) kind = 2;
        else { l = (ph - 2) / 9; k = (ph - 2) % 9; li = l >> 1; const bool attn = (l & 1) == 0;
            kind = (k == 0 || k == 5) ? 2 : k == 1 ? (attn ? 3 : 6) : k == 2 ? (attn ? 4 : 7) : k == 3 ? 8 : (k == 4 || k == 8) ? 5 : k == 6 ? 9 : 10; }
        if (it % DBG_REP_N != 0 && !(kind == DBG_REP_KIND && ph != 38)) continue;
        if (kind == 0) { if (DM_(0)) prologue_phase(P, lds, gw, NGW, lane, wave); }
        else if (kind == 1) { if (DM_(1)) { pg8::Gemm g{(const bf16_t*)(ws + WS_SC), (const bf16_t*)(ws + WS_R1), 256, MODW, DM}; pg8::StaticOrder S; S.init(256, MODW, G, bx);
            EpiAda E{mod, P->in[I_BADA]}; pg8::gemm_phase<EpiAda, pg8::StaticOrder, true, true>(lds, g, S, E); } }
        else if (kind == 2) { if (DM_(2)) norm_phase(P, l, ph == 38 ? 2 : (k == 5 ? 1 : 0), ph == 2, ph == 2 ? 0 : (ph == 38 || k == 0) ? 11 : 8, gw, NGW, lane); }
        else if (kind == 3) { if (DM_(3)) { pg8::Gemm g{XN, (const bf16_t*)(ws + WS_WQKV) + (size_t)li * QKVN * DM, M, QKVN, DM}; pg8::StaticOrder S; S.init(M, QKVN, G, bx);
            EpiQKV E{(bf16_t*)(ws + WS_R1), (bf16_t*)(ws + WS_R1 + 34 * MiB), (bf16_t*)(ws + WS_R1 + 43 * MiB), P->in[I_BQKV] + li * QKVN, (const float*)(ws + WS_ROPE),
                     P->out + O_KP + (size_t)li * 65536, P->out + O_VP + (size_t)li * 65536, P->out + O_KS + (size_t)li * 4194304, P->out + O_VS + (size_t)li * 4194304};
            pg8::gemm_phase<EpiQKV, pg8::StaticOrder, true, true>(lds, g, S, E); } }
        else if (kind == 4) { if (DM_(4)) attn_phase(P, li, lds, vcu, G, tid, wave, lane); }
        else if (kind == 5) { if (DM_(5)) {
            const bf16_t* A; const bf16_t* Bt; int K; int part = 2;
            if (k == 8) { A = (const bf16_t*)(ws + WS_R2); Bt = (const bf16_t*)(ws + WS_WDN) + (size_t)l * DM * DFF; K = DFF; part = 5; }
            else if ((l & 1) == 0) { A = (const bf16_t*)(ws + WS_R1 + 52 * MiB); Bt = (const bf16_t*)(ws + WS_WO) + (size_t)li * DM * DM; K = DM; }
            else { A = (const bf16_t*)(ws + WS_R1); Bt = (const bf16_t*)(ws + WS_WSO) + (size_t)li * DM * DSGU; K = DSGU; }
            const int ns = K == DFF ? 11 : 8, ntk = K / 64 / ns;
            pg8::Gemm g{A, Bt, M, DM, K}; ResidOrder S; S.init(G, bx, ns, ntk);
            EpiResid E{P->out, mod + l * 6144 + part * DM, (float*)(ws + WS_PART), ntk, (DBG_REP_KIND == 5 && DBG_REP_N > 1 && it % DBG_REP_N == 0) ? 0.f : 1.f}; pg8::gemm_phase<EpiResid, ResidOrder, true, true>(lds, g, S, E); } }
        else if (kind == 6) { if (DM_(6)) { pg8::Gemm g{XN, (const bf16_t*)(ws + WS_WSI) + (size_t)li * 2 * DSGU * DM, M, 2 * DSGU, DM}; pg8::StaticOrder S; S.init(M, 2 * DSGU, G, bx);
            EpiGelu E{(bf16_t*)(ws + WS_R1), (bf16_t*)(ws + WS_R1 + (size_t)M * DSGU * 2), P->in[I_BSI] + li * 2 * DSGU, (float*)(ws + WS_RSTAT) + (size_t)li * M * 2}; pg8::gemm_phase<EpiGelu, pg8::StaticOrder, true, true>(lds, g, S, E); } }
        else if (kind == 8) { if (DM_(8)) mix_phase(P, li, lds, vcu, G, tid, wave, lane, DBG_REP_KIND == 8 && DBG_REP_N > 1 && it % DBG_REP_N == 0); }
        else if (kind == 9) { if (DM_(9)) { pg8::Gemm g{XN, (const bf16_t*)(ws + WS_WUP) + (size_t)l * DFF2 * DM, M, DFF2, DM}; pg8::StaticOrder S; S.init(M, DFF2, G, bx);
            EpiUp E{(bf16_t*)(ws + WS_R1), P->out + O_CP + (size_t)l * 2 * 2 * DFF2, P->out + O_CS + (size_t)l * 128 * 2 * DFF2}; pg8::gemm_phase<EpiUp, pg8::StaticOrder, true, true>(lds, g, S, E); } }
        else { if (DM_(10)) conv_phase(P, l, bx * NTHR + tid, G * NTHR); }
        if (it + 1 < ph_hi * DBG_REP_N) { for (int sr = 0; sr < DBG_SYNC_N; ++sr) { if (ph_hi < 0) { __syncthreads(); cg::this_grid().sync(); } else xcd_barrier(xbar); } }
    }
}

extern "C" void kernel_launch(void* const* d_in, const int* in_sizes, int n_in, void* d_out, int out_size, void* d_ws, size_t ws_size, hipStream_t stream) {
    static int grid = 0;
    if (grid == 0) {
        if (n_in != 27 || (size_t)out_size != O_END || ws_size < WS_END) { fprintf(stderr, "kernel_launch: unexpected shapes: n_in %d out %d ws %zu\n", n_in, out_size, ws_size); grid = -1; return; }
        int dev = 0, cus = 0, per_cu = 0;
        hipGetDevice(&dev); hipDeviceGetAttribute(&cus, hipDeviceAttributeMultiprocessorCount, dev);
        if (hipFuncSetAttribute((const void*)fwd_kernel, hipFuncAttributeMaxDynamicSharedMemorySize, LDS_BYTES) != hipSuccess) { fprintf(stderr, "kernel_launch: hipFuncSetAttribute failed\n"); grid = -1; return; }
        if (hipOccupancyMaxActiveBlocksPerMultiprocessor(&per_cu, (const void*)fwd_kernel, NTHR, LDS_BYTES) != hipSuccess || per_cu < 1) { fprintf(stderr, "kernel_launch: occupancy query says %d\n", per_cu); (void)hipGetLastError(); grid = -1; return; }
        grid = cus;
    }
    if (grid < 0) return;
    Params p; memset(&p, 0, sizeof(p));
    for (int i = 0; i < 27; ++i) p.in[i] = (const float*)d_in[i];
    p.out = (float*)d_out; p.ws = (unsigned char*)d_ws;
    for (int i = 0; i < 8; ++i) p.inv[i] = pow(500000.0, -(double)i / 8.0);
#if MK_PER_PHASE
    for (int ph = 0; ph < N_PHASES; ++ph) { bool act = (ph < 2 || ph == 38) || !((((ph - 2) / 9) & 1) == 0 && (ph - 2) % 9 == 3); if (!act) continue;
        p.ph_lo = ph; p.ph_hi = ph + 1; hipLaunchKernelGGL(fwd_kernel, dim3(grid), dim3(NTHR), LDS_BYTES, stream, p); }
#else
    if (hipMemsetAsync(d_ws, 0, 65536, stream) != hipSuccess) { fprintf(stderr, "kernel_launch: memset failed\n"); return; }
    p.ph_lo = 0; p.ph_hi = N_PHASES; void* args[] = {&p};
    hipError_t e = hipLaunchCooperativeKernel((const void*)fwd_kernel, dim3(grid), dim3(NTHR), args, LDS_BYTES, stream);
    if (e != hipSuccess) fprintf(stderr, "kernel_launch: cooperative launch failed: %s (grid %d)\n", hipGetErrorString(e), grid);
#endif
}
```

```cpp
#include <hip/hip_runtime.h>
#include <hip/hip_cooperative_groups.h>
#include <cstdio>
#include <cstdint>
#include <cstring>
#include <cmath>
namespace cg = cooperative_groups;
namespace pg8 {
#define PG8_LAS __attribute__((address_space(3)))
typedef unsigned short bf16_t;
typedef short bf16x8 __attribute__((ext_vector_type(8)));
typedef float f32x4 __attribute__((ext_vector_type(4)));
typedef unsigned u32x4 __attribute__((ext_vector_type(4)));
constexpr int BM = 256, BK = 64, HALF = 128, HTB = HALF * BK * 2  , STAGE_BYTES = 8 * HTB, NXCD = 8, WGM = 8;

__host__ __device__ __forceinline__ int lds_byte(int r, int c) { const int st = (r >> 4) * 2 + (c >> 5), rr = r & 15, cc = c & 31, ob = rr * 64 + cc * 2; return st * 1024 + (ob ^ (((ob >> 9) & 1) << 5)); }
__host__ __device__ __forceinline__ void stage_rc(int b, int& R, int& C) { const int st = b / 1024, sb = b % 1024, swz = sb ^ (((sb >> 9) & 1) << 5); R = (st >> 1) * 16 + swz / 64; C = (st & 1) * 32 + (swz % 64) / 2; }
__host__ __device__ __forceinline__ int perm32(int rho) { const int n = rho >> 4, i = rho & 15; return 8 * (i >> 2) + 4 * n + (i & 3); }

struct Unit { int pm, pn, k0, nt; };
struct Gemm { const bf16_t* A; const bf16_t* Bt; int M, N, K; };

struct StaticOrder {
    int nM, nN, nwg, G, c;
    __host__ __device__ void init(int M, int N, int G_, int c_) { nM = M / BM; nN = N / BM; nwg = nM * nN; G = G_; c = c_; }
    __host__ __device__ bool next(int i, Unit& u) const {
        const long L = (long)i * G + c; if (L >= nwg) return false;
        int wgid = (int)L; { const int q = nwg / NXCD, r = nwg % NXCD, xcd = wgid % NXCD, off = wgid / NXCD; wgid = (xcd < r ? xcd * (q + 1) : r * (q + 1) + (xcd - r) * q) + off; }
        const int nig = WGM * nN, gid = wgid / nig, fm = gid * WGM, gsz = (nM - fm) < WGM ? (nM - fm) : WGM;
        u.pm = fm + ((wgid % nig) % gsz); u.pn = (wgid % nig) / gsz; u.k0 = 0; u.nt = 0; return true;
    }
    __device__ __forceinline__ void a_ready(const Unit&) const {}
    __device__ __forceinline__ void done(const Unit&) const {}
};

__device__ __forceinline__ unsigned cvt_pk_bf16(float lo, float hi) { unsigned r; asm volatile("v_cvt_pk_bf16_f32 %0, %1, %2" : "=v"(r) : "v"(lo), "v"(hi)); return r; }
typedef float f32x2 __attribute__((ext_vector_type(2)));
template <class Epi, class Sched, bool ALIGN_EPI = false, bool SP2 = false>
__device__ __forceinline__ void gemm_phase(PG8_LAS unsigned char* lds, const Gemm g, const Sched& S, const Epi& E) {
    int tid_ = threadIdx.x; asm volatile("" : "+v"(tid_));
    const int tid = tid_, wid = __builtin_amdgcn_readfirstlane(tid >> 6), lane = tid & 63, wr = wid >> 2, wc = wid & 3, fr = lane & 15, fq = lane >> 4;
    const int K = g.K, nt = K / BK;
    unsigned voffA[2], voffB[2];
#pragma unroll
    for (int i = 0; i < 2; ++i) { int R, C; stage_rc(tid * 16 + i * 8192, R, C); const int Rb = Epi::PERM ? ((R & ~31) + perm32(R & 31)) : R;
        voffA[i] = (unsigned)(R * K + C) * 2u; voffB[i] = (unsigned)(Rb * K + C) * 2u; }
    const size_t kstep = (size_t)(BK * 2);
    const size_t hstep = (size_t)HALF * K * 2;
    const size_t tstep = 2 * hstep;
    const unsigned ldsw = (unsigned)wid * 1024u;
    const int aoff = lds_byte(wr * 64 + fr, fq * 8), boff = lds_byte(wc * 32 + fr, fq * 8);
#define PG8_SA(b, h) (((b) * 2 + (h)) * HTB)
#define PG8_SB(b, h) ((4 + (b) * 2 + (h)) * HTB)
#define PG8_STAGE(bufoff, gbase, voff) do { _Pragma("unroll") for (int _i = 0; _i < 2; ++_i) \
        __builtin_amdgcn_global_load_lds((const unsigned*)((const char*)(gbase) + (voff)[_i]), (PG8_LAS unsigned*)(lds + (bufoff) + ldsw + _i * 8192), 16, 0, 0); } while (0)
#define PG8_LDA(dst, b, h) do { _Pragma("unroll") for (int m = 0; m < 4; ++m) _Pragma("unroll") for (int k = 0; k < 2; ++k) dst[m][k] = *(const PG8_LAS bf16x8*)(lds + PG8_SA(b, h) + aoff + m * 2048 + k * 1024); } while (0)
#define PG8_LDB(dst, b, h) do { _Pragma("unroll") for (int n = 0; n < 2; ++n) _Pragma("unroll") for (int k = 0; k < 2; ++k) dst[n][k] = *(const PG8_LAS bf16x8*)(lds + PG8_SB(b, h) + boff + n * 2048 + k * 1024); } while (0)
#define PG8_MMA(ai, bj, At, Bt) do { __builtin_amdgcn_s_setprio(1); _Pragma("unroll") for (int m = 0; m < 4; ++m) _Pragma("unroll") for (int n = 0; n < 2; ++n) _Pragma("unroll") for (int k = 0; k < 2; ++k) \
        acc[ai][bj][m][n] = __builtin_amdgcn_mfma_f32_16x16x32_bf16(Bt[n][k], At[m][k], acc[ai][bj][m][n], 0, 0, 0); __builtin_amdgcn_s_setprio(0); } while (0)
#define PG8_WAIT_V(n) asm volatile("s_waitcnt vmcnt(" #n ")" ::: "memory")
#define PG8_WAIT_L(n) asm volatile("s_waitcnt lgkmcnt(" #n ")" ::: "memory")
#define PG8_BAR __builtin_amdgcn_s_barrier()
#define PG8_SCHED __builtin_amdgcn_sched_barrier(0)
    Unit cur, nxt; int ui = 0;
    if (!S.next(0, cur)) return;
    f32x4 acc[2][2][4][2];
#pragma unroll
    for (int a = 0; a < 2; ++a)
#pragma unroll
        for (int b = 0; b < 2; ++b)
#pragma unroll
            for (int m = 0; m < 4; ++m)
#pragma unroll
                for (int n = 0; n < 2; ++n) acc[a][b][m][n] = (f32x4){0.f, 0.f, 0.f, 0.f};
    if constexpr (Epi::HAS_INIT) E.init(acc, cur, wr, wc, fr, fq);
    bf16x8 At[4][2], B0[2][2], B1[2][2];
    const char* cA = (const char*)g.A + (size_t)cur.pm * tstep + (size_t)cur.k0 * kstep; const char* cB = (const char*)g.Bt + (size_t)cur.pn * tstep + (size_t)cur.k0 * kstep;
    S.a_ready(cur);
    if constexpr (SP2) {
        PG8_STAGE(PG8_SB(0, 0), cB, voffB); PG8_STAGE(PG8_SB(0, 1), cB + hstep, voffB); PG8_STAGE(PG8_SA(0, 0), cA, voffA); PG8_STAGE(PG8_SA(0, 1), cA + hstep, voffA);
        if (wr == 1) PG8_BAR;
        PG8_WAIT_V(2); PG8_BAR;
        PG8_STAGE(PG8_SB(1, 0), cB + kstep, voffB); PG8_STAGE(PG8_SA(1, 0), cA + kstep, voffA); PG8_STAGE(PG8_SB(1, 1), cB + hstep + kstep, voffB);
        PG8_WAIT_V(6); PG8_BAR;
    } else {
        PG8_STAGE(PG8_SB(0, 0), cB, voffB); PG8_STAGE(PG8_SA(0, 0), cA, voffA); PG8_STAGE(PG8_SB(0, 1), cB + hstep, voffB); PG8_STAGE(PG8_SA(0, 1), cA + hstep, voffA);
        if (wr == 1) PG8_BAR;
        PG8_WAIT_V(4); PG8_BAR;
        PG8_STAGE(PG8_SB(1, 0), cB + kstep, voffB); PG8_STAGE(PG8_SA(1, 0), cA + kstep, voffA); PG8_STAGE(PG8_SB(1, 1), cB + hstep + kstep, voffB);
        PG8_WAIT_V(6); PG8_BAR;
    }
    for (;;) {
        const bool has_next = S.next(ui + 1, nxt);
        const char* nA = has_next ? (const char*)g.A + (size_t)nxt.pm * tstep + (size_t)nxt.k0 * kstep : cA; const char* nB = has_next ? (const char*)g.Bt + (size_t)nxt.pn * tstep + (size_t)nxt.k0 * kstep : cB;
        const int cnt = cur.nt ? cur.nt : nt;
        for (int t = 0; t < cnt; t += 2) {
            const bool last = (t == cnt - 2);
            const char* a1 = cA + (size_t)(t + 1) * kstep;
            const char* a2 = last ? nA : cA + (size_t)(t + 2) * kstep; const char* b2 = last ? nB : cB + (size_t)(t + 2) * kstep;
            const char* a3 = a2 + kstep; const char* b3 = b2 + kstep;
            if (last && has_next) S.a_ready(nxt);
            if constexpr (SP2) {
            PG8_LDB(B0, 0, 0); PG8_LDB(B1, 0, 1); PG8_SCHED; PG8_LDA(At, 0, 0); PG8_STAGE(PG8_SA(1, 1), a1 + hstep, voffA);
            PG8_WAIT_V(8); PG8_WAIT_L(0); PG8_BAR; PG8_MMA(0, 0, At, B0); PG8_MMA(0, 1, At, B1); PG8_BAR; PG8_SCHED;
            PG8_LDA(At, 0, 1); PG8_STAGE(PG8_SB(0, 0), b2, voffB); PG8_STAGE(PG8_SB(0, 1), b2 + hstep, voffB); PG8_STAGE(PG8_SA(0, 0), a2, voffA);
            PG8_WAIT_V(8); PG8_WAIT_L(0); PG8_BAR; PG8_MMA(1, 0, At, B0); PG8_MMA(1, 1, At, B1); PG8_BAR; PG8_SCHED;
            PG8_LDB(B0, 1, 0); PG8_LDB(B1, 1, 1); PG8_SCHED; PG8_LDA(At, 1, 0); PG8_STAGE(PG8_SA(0, 1), a2 + hstep, voffA);
            PG8_WAIT_V(8); PG8_WAIT_L(0); PG8_BAR; PG8_MMA(0, 0, At, B0); PG8_MMA(0, 1, At, B1); PG8_BAR; PG8_SCHED;
            PG8_LDA(At, 1, 1); PG8_STAGE(PG8_SB(1, 0), b3, voffB); PG8_STAGE(PG8_SB(1, 1), b3 + hstep, voffB); PG8_STAGE(PG8_SA(1, 0), a3, voffA);
            PG8_WAIT_V(8); PG8_WAIT_L(0); PG8_BAR; PG8_MMA(1, 0, At, B0); PG8_MMA(1, 1, At, B1); PG8_BAR; PG8_SCHED;
            } else {
            PG8_LDB(B0, 0, 0); PG8_SCHED; PG8_LDA(At, 0, 0); PG8_STAGE(PG8_SA(1, 1), a1 + hstep, voffA);
            PG8_WAIT_L(8); PG8_BAR; PG8_WAIT_L(0); PG8_MMA(0, 0, At, B0); PG8_BAR; PG8_SCHED;
            PG8_LDB(B1, 0, 1); PG8_STAGE(PG8_SB(0, 0), b2, voffB);
            PG8_BAR; PG8_WAIT_L(0); PG8_MMA(0, 1, At, B1); PG8_BAR;
            PG8_LDA(At, 0, 1); PG8_STAGE(PG8_SA(0, 0), a2, voffA);
            PG8_BAR; PG8_WAIT_L(0); PG8_MMA(1, 0, At, B0); PG8_BAR; PG8_SCHED;
            PG8_STAGE(PG8_SB(0, 1), b2 + hstep, voffB);
            PG8_WAIT_V(6); PG8_BAR; PG8_MMA(1, 1, At, B1); PG8_BAR;
            PG8_LDB(B0, 1, 0); PG8_SCHED; PG8_LDA(At, 1, 0); PG8_STAGE(PG8_SA(0, 1), a2 + hstep, voffA);
            PG8_WAIT_L(8); PG8_BAR; PG8_WAIT_L(0); PG8_MMA(0, 0, At, B0); PG8_BAR; PG8_SCHED;
            PG8_LDB(B1, 1, 1); PG8_STAGE(PG8_SB(1, 0), b3, voffB);
            PG8_BAR; PG8_WAIT_L(0); PG8_MMA(0, 1, At, B1); PG8_BAR;
            PG8_LDA(At, 1, 1); PG8_STAGE(PG8_SA(1, 0), a3, voffA);
            PG8_BAR; PG8_WAIT_L(0); PG8_MMA(1, 0, At, B0); PG8_BAR; PG8_SCHED;
            PG8_STAGE(PG8_SB(1, 1), b3 + hstep, voffB);
            PG8_WAIT_V(6); PG8_BAR; PG8_MMA(1, 1, At, B1); PG8_BAR;
            }
        }
        if constexpr (ALIGN_EPI) { if (wr == 0) PG8_BAR; }
        if constexpr (!Epi::AFTER_DRAIN) { E(acc, cur, wr, wc, fr, fq); S.done(cur); }
        if (!has_next) break;
#pragma unroll
        for (int a = 0; a < 2; ++a)
#pragma unroll
            for (int b = 0; b < 2; ++b)
#pragma unroll
                for (int m = 0; m < 4; ++m)
#pragma unroll
                    for (int n = 0; n < 2; ++n) acc[a][b][m][n] = (f32x4){0.f, 0.f, 0.f, 0.f};
        cur = nxt; cA = nA; cB = nB; ++ui;
        if constexpr (Epi::HAS_INIT) E.init(acc, cur, wr, wc, fr, fq);
        if constexpr (ALIGN_EPI) { if (wr == 1) PG8_BAR; }
    }
    PG8_WAIT_V(0);
    if constexpr (!ALIGN_EPI) { if (wr == 0) PG8_BAR; }
    PG8_BAR;
    if constexpr (Epi::AFTER_DRAIN) { E.fused(acc, cur, wr, wc, fr, fq, lds, wid, lane); S.done(cur); }
#undef PG8_SA
#undef PG8_SB
#undef PG8_STAGE
#undef PG8_LDA
#undef PG8_LDB
#undef PG8_MMA
#undef PG8_WAIT_V
#undef PG8_WAIT_L
#undef PG8_BAR
#undef PG8_SCHED
}
}

#ifndef MK_PER_PHASE
#define MK_PER_PHASE 0
#endif
using pg8::bf16_t; using pg8::bf16x8; using pg8::f32x4; using pg8::u32x4; using pg8::cvt_pk_bf16; using pg8::Unit;
#ifndef LAS
#define LAS __attribute__((address_space(3)))
#endif
typedef unsigned u32x2 __attribute__((ext_vector_type(2)));
constexpr int DM = 1024, MP = 16384, MS = 1024, M = MP + MS, SEQ = 8192, NSEQ = 130, DEPTH = 4;
constexpr int DFF = 2816, DFF2 = 5632, DSGU = 2048, QKVN = 1536, MODW = 6144 * DEPTH, NPOS = 8200;
constexpr float EPS = 1e-6f, LOG2E = 1.4426950408889634f, QSCALE = 0.125f * LOG2E;
constexpr int NWAVES = 8, NTHR = 512;
constexpr size_t O_Y = 0, O_KP = (size_t)M * DM, O_VP = O_KP + 131072, O_CP = O_VP + 131072, O_KS = O_CP + 90112,
                 O_VS = O_KS + 8388608, O_CS = O_VS + 8388608, O_SG = O_CS + 5767168, O_END = O_SG + 4194304;
constexpr size_t MiB = 1u << 20;
constexpr size_t WS_RSTAT = 128 * 1024  , WS_WTRI = 2 * MiB + 512 * 1024  ;
constexpr size_t WS_ROPE = 1 * MiB, WS_SC = 2 * MiB, WS_MOD = 3 * MiB, WS_WQKV = 16 * MiB, WS_WO = 22 * MiB, WS_WSI = 26 * MiB, WS_WSO = 42 * MiB,
                 WS_WUP = 50 * MiB, WS_WDN = 94 * MiB, WS_R2 = 116 * MiB, WS_R1 = 210 * MiB, WS_END = 397 * MiB;
constexpr size_t WS_PART = WS_R1 + 140 * MiB;
static_assert(WS_PART + 11 * (size_t)MS * DM * 4 <= WS_END, "partials");
static_assert(WS_R2 + (size_t)M * DFF * 2 <= WS_R1 && WS_R1 + (size_t)M * DFF2 * 2 <= WS_END && WS_MOD + (size_t)NSEQ * MODW * 4 <= WS_WQKV, "ws map");
constexpr int LDS_BYTES = 147456;

struct Params { const float* in[27]; float* out; unsigned char* ws; double inv[8]; int ph_lo, ph_hi; };
#define CAS __attribute__((address_space(4)))
typedef const CAS Params* PPtr;
enum { I_XP = 0, I_XS, I_CP, I_CS, I_CK, I_CV, I_SCONV, I_WADA, I_BADA, I_NMIX, I_NFFN, I_WQKV, I_BQKV, I_SINK, I_WO, I_WSI, I_BSI, I_LNG, I_LNB,
       I_WSP, I_BSP, I_WSO, I_WUP, I_CW, I_CB, I_WDN, I_NFIN };

__device__ __forceinline__ void row_info(int r, int& seq, int& t) { if (r < MP) { seq = r >> 13; t = r & 8191; } else { const int q = r - MP; seq = 2 + (q >> 3); t = q & 7; } }
__device__ __forceinline__ float wave_sum(float v) {
#pragma unroll
    for (int o = 1; o < 64; o <<= 1) v += __shfl_xor(v, o);
    return v;
}
__device__ __forceinline__ float bf2f(unsigned h) { return __uint_as_float(h << 16); }
__device__ __forceinline__ u32x4 pack8(const f32x4 a, const f32x4 b) { u32x4 w; w.x = cvt_pk_bf16(a[0], a[1]); w.y = cvt_pk_bf16(a[2], a[3]); w.z = cvt_pk_bf16(b[0], b[1]); w.w = cvt_pk_bf16(b[2], b[3]); return w; }

#ifndef NT_STORES
#define NT_STORES 0
#endif
__device__ __forceinline__ void st16(void* p, u32x4 v) { if (NT_STORES) __builtin_nontemporal_store(v, (u32x4*)p); else *(u32x4*)p = v; }
__device__ __forceinline__ void st8(void* p, u32x2 v) { if (NT_STORES) __builtin_nontemporal_store(v, (u32x2*)p); else *(u32x2*)p = v; }
struct EpiAda { static constexpr bool PERM = true, AFTER_DRAIN = false, HAS_INIT = false; float* mod; const float* bias;
    __device__ __forceinline__ void operator()(const f32x4 (&acc)[2][2][4][2], const Unit& u, int wr, int wc, int fr, int fq) const {
        const int row0 = u.pm * 256 + wr * 64 + fr, col0 = u.pn * 256 + wc * 32 + 8 * fq;
        f32x4 bv[2][2];
#pragma unroll
        for (int bj = 0; bj < 2; ++bj)
#pragma unroll
            for (int n = 0; n < 2; ++n) bv[bj][n] = *(const f32x4*)(bias + col0 + bj * 128 + 4 * n);
#pragma unroll
        for (int ai = 0; ai < 2; ++ai)
#pragma unroll
            for (int m = 0; m < 4; ++m) { const int r = row0 + ai * 128 + m * 16; if (r < NSEQ) {
#pragma unroll
                for (int bj = 0; bj < 2; ++bj) { float* d = mod + (size_t)r * MODW + col0 + bj * 128;
                    *(f32x4*)d = acc[ai][bj][m][0] + bv[bj][0]; *(f32x4*)(d + 4) = acc[ai][bj][m][1] + bv[bj][1]; } } }
    }
};
__device__ __forceinline__ f32x4 gate_safe(f32x4 g) { f32x4 r;
#pragma unroll
    for (int e = 0; e < 4; ++e) r[e] = __builtin_copysignf(fmaxf(fabsf(g[e]), 1e-30f), g[e]);
    return r; }
struct EpiResid { static constexpr bool PERM = false, AFTER_DRAIN = false, HAS_INIT = false;     float* x; const float* gate; float* part; int ntk; float gscale;
    __device__ __forceinline__ void init(f32x4 (&acc)[2][2][4][2], const Unit& u, int wr, int wc, int fr, int fq) const {
        if (u.nt) return;
        const int row0 = u.pm * 256 + wr * 64 + fr, col0 = u.pn * 256 + wc * 32 + 4 * fq;
#pragma unroll
        for (int ai = 0; ai < 2; ++ai)
#pragma unroll
            for (int m = 0; m < 4; ++m) { const int r = row0 + ai * 128 + m * 16; int seq, t; row_info(r, seq, t);
                const float* xr = x + (size_t)r * DM + col0; const float* gr = gate + (size_t)seq * MODW + col0;
#pragma unroll
                for (int bj = 0; bj < 2; ++bj)
#pragma unroll
                    for (int n = 0; n < 2; ++n) { const int o = bj * 128 + 16 * n; const f32x4 xv = *(const f32x4*)(xr + o), gv = gate_safe(*(const f32x4*)(gr + o));
#pragma unroll
                        for (int e = 0; e < 4; ++e) acc[ai][bj][m][n][e] = xv[e] * __builtin_amdgcn_rcpf(gv[e]); } }
    }
    __device__ __forceinline__ void operator()(const f32x4 (&acc)[2][2][4][2], const Unit& u, int wr, int wc, int fr, int fq) const {
        const int row0 = u.pm * 256 + wr * 64 + fr, col0 = u.pn * 256 + wc * 32 + 4 * fq;
        if (u.nt) {
#pragma unroll
            for (int ai = 0; ai < 2; ++ai) { f32x4 gq[4][2][2];
#pragma unroll
                for (int m = 0; m < 4; ++m) { const int r = row0 + ai * 128 + m * 16; int seq, t; row_info(r, seq, t); const float* gr = gate + (size_t)seq * MODW + col0;
#pragma unroll
                    for (int bj = 0; bj < 2; ++bj)
#pragma unroll
                        for (int n = 0; n < 2; ++n) gq[m][bj][n] = *(const f32x4*)(gr + bj * 128 + 16 * n); }
#pragma unroll
                for (int m = 0; m < 4; ++m) { const int r = row0 + ai * 128 + m * 16; float* pr = part + ((size_t)(u.k0 / ntk) * MS + (r - MP)) * DM + col0;
#pragma unroll
                    for (int bj = 0; bj < 2; ++bj)
#pragma unroll
                        for (int n = 0; n < 2; ++n) *(f32x4*)(pr + bj * 128 + 16 * n) = gq[m][bj][n] * gscale * acc[ai][bj][m][n]; }
                asm volatile("" ::: "memory"); }
        } else {
            int seq0, t0; row_info(u.pm * 256, seq0, t0); const float* gr = gate + (size_t)seq0 * MODW + col0;
            f32x4 gv[2][2];
#pragma unroll
            for (int bj = 0; bj < 2; ++bj)
#pragma unroll
                for (int n = 0; n < 2; ++n) gv[bj][n] = *(const f32x4*)(gr + bj * 128 + 16 * n) * gscale;
#pragma unroll
            for (int ai = 0; ai < 2; ++ai) { f32x4 xv[4][2][2];
#pragma unroll
                for (int m = 0; m < 4; ++m)
#pragma unroll
                    for (int bj = 0; bj < 2; ++bj)
#pragma unroll
                        for (int n = 0; n < 2; ++n) xv[m][bj][n] = *(const f32x4*)(x + (size_t)(row0 + ai * 128 + m * 16) * DM + col0 + bj * 128 + 16 * n);
#pragma unroll
                for (int m = 0; m < 4; ++m)
#pragma unroll
                    for (int bj = 0; bj < 2; ++bj)
#pragma unroll
                        for (int n = 0; n < 2; ++n) *(f32x4*)(x + (size_t)(row0 + ai * 128 + m * 16) * DM + col0 + bj * 128 + 16 * n) = xv[m][bj][n] + gv[bj][n] * acc[ai][bj][m][n];
                asm volatile("" ::: "memory"); }
        }
    }
};
__device__ __forceinline__ float gelu_tanh(float x) { const float y = x * (1.0f + 0.044715f * x * x) * (1.5957691216057308f * LOG2E); return x * __builtin_amdgcn_rcpf(1.0f + __builtin_amdgcn_exp2f(-y)); }
struct EpiGelu { static constexpr bool PERM = true, AFTER_DRAIN = false, HAS_INIT = false; bf16_t* U; bf16_t* V; const float* bias; float* rstat;
    __device__ __forceinline__ void operator()(const f32x4 (&acc)[2][2][4][2], const Unit& u, int wr, int wc, int fr, int fq) const {
        const int row0 = u.pm * 256 + wr * 64 + fr, colt = u.pn * 256, col0 = colt + wc * 32 + 8 * fq;
        bf16_t* base = (colt < DSGU ? U : V) + ((col0) & (DSGU - 1));
        f32x4 bv[2][2];
#pragma unroll
        for (int bj = 0; bj < 2; ++bj)
#pragma unroll
            for (int n = 0; n < 2; ++n) bv[bj][n] = *(const f32x4*)(bias + col0 + bj * 128 + 4 * n);
#pragma unroll
        for (int ai = 0; ai < 2; ++ai)
#pragma unroll
            for (int m = 0; m < 4; ++m) { const int r = row0 + ai * 128 + m * 16; float s1 = 0.f, s2 = 0.f;
#pragma unroll
                for (int bj = 0; bj < 2; ++bj) { f32x4 v0 = acc[ai][bj][m][0] + bv[bj][0], v1 = acc[ai][bj][m][1] + bv[bj][1];
#pragma unroll
                    for (int e = 0; e < 4; ++e) { v0[e] = gelu_tanh(v0[e]); v1[e] = gelu_tanh(v1[e]); s1 += v0[e] + v1[e]; s2 += v0[e] * v0[e] + v1[e] * v1[e]; }
                    st16(base + (size_t)r * DSGU + bj * 128, pack8(v0, v1)); }
                if (colt >= DSGU) { s1 += __shfl_xor(s1, 16); s2 += __shfl_xor(s2, 16); s1 += __shfl_xor(s1, 32); s2 += __shfl_xor(s2, 32);
                    if (fq == 0) { unsafeAtomicAdd(rstat + 2 * r, s1); unsafeAtomicAdd(rstat + 2 * r + 1, s2); } } }
    }
};
struct EpiUp { static constexpr bool PERM = true, AFTER_DRAIN = false, HAS_INIT = false; bf16_t* a; float* ocp; float* ocs;
    __device__ __forceinline__ void operator()(const f32x4 (&acc)[2][2][4][2], const Unit& u, int wr, int wc, int fr, int fq) const {
        const int row0 = u.pm * 256 + wr * 64 + fr, col0 = u.pn * 256 + wc * 32 + 8 * fq;
#pragma unroll
        for (int ai = 0; ai < 2; ++ai)
#pragma unroll
            for (int m = 0; m < 4; ++m) { const int r = row0 + ai * 128 + m * 16; int seq, t; row_info(r, seq, t);
                float* tail = nullptr;
                if (r < MP) { if (t >= SEQ - 2) tail = ocp + (size_t)(seq * 2 + (t - (SEQ - 2))) * DFF2; }
                else if (t >= 6) tail = ocs + (size_t)((seq - 2) * 2 + (t - 6)) * DFF2;
#pragma unroll
                for (int bj = 0; bj < 2; ++bj) { const int c = col0 + bj * 128;
                    st16(a + (size_t)r * DFF2 + c, pack8(acc[ai][bj][m][0], acc[ai][bj][m][1]));
                    if (tail) { *(f32x4*)(tail + c) = acc[ai][bj][m][0]; *(f32x4*)(tail + c + 4) = acc[ai][bj][m][1]; } } }
    }
};
struct EpiQKV { static constexpr bool PERM = true, AFTER_DRAIN = false, HAS_INIT = false; bf16_t *Q, *K, *V; const float* bias; const float* rope; float *okp, *ovp, *oks, *ovs;
    __device__ __forceinline__ void operator()(const f32x4 (&acc)[2][2][4][2], const Unit& u, int wr, int wc, int fr, int fq) const {
        const int row0 = u.pm * 256 + wr * 64 + fr, colt = u.pn * 256, col0 = colt + wc * 32 + 8 * fq;
        const int kind = colt < 1024 ? 0 : (colt < 1280 ? 1 : 2);
        const bool do_rope = kind < 2 && (wc & 1) == 0;
        const float sgn = fq == 0 ? -1.f : 1.f;
        f32x4 bv[2][2];
#pragma unroll
        for (int bj = 0; bj < 2; ++bj)
#pragma unroll
            for (int n = 0; n < 2; ++n) bv[bj][n] = *(const f32x4*)(bias + col0 + bj * 128 + 4 * n);
        f32x4 rc0[2], rc1[2], rs0[2], rs1[2];
#pragma unroll
        for (int mm = 0; mm < 2; ++mm) { rc0[mm] = rc1[mm] = (f32x4){1.f, 1.f, 1.f, 1.f}; rs0[mm] = rs1[mm] = (f32x4){0.f, 0.f, 0.f, 0.f}; }
#pragma unroll
        for (int ai = 0; ai < 2; ++ai)
#pragma unroll
            for (int m = 0; m < 4; ++m) { const int r = row0 + ai * 128 + m * 16; int seq, t; row_info(r, seq, t);
                if ((m & 1) == 0 && do_rope && fq < 2) {
#pragma unroll
                    for (int mm = m; mm < m + 2; ++mm) { const int r_ = row0 + ai * 128 + mm * 16; int sq_, t_; row_info(r_, sq_, t_); const float* rp = rope + (size_t)(r_ < MP ? t_ : SEQ + t_) * 16;
                        rc0[mm & 1] = *(const f32x4*)rp; rc1[mm & 1] = *(const f32x4*)(rp + 4); rs0[mm & 1] = *(const f32x4*)(rp + 8) * sgn; rs1[mm & 1] = *(const f32x4*)(rp + 12) * sgn; } }
                const f32x4 c0 = rc0[m & 1], c1 = rc1[m & 1], s0 = rs0[m & 1], s1 = rs1[m & 1];
                float* tk = nullptr;
                if (kind > 0) { float* ob_p = kind == 1 ? okp : ovp; float* ob_s = kind == 1 ? oks : ovs;
                    if (r < MP) { if (t >= SEQ - 128) tk = ob_p + (size_t)(seq * 128 + (t - (SEQ - 128))) * 256; }
                    else tk = ob_s + (size_t)((seq - 2) * 128 + 120 + t) * 256; }
#pragma unroll
                for (int bj = 0; bj < 2; ++bj) { f32x4 v0 = acc[ai][bj][m][0] + bv[bj][0], v1 = acc[ai][bj][m][1] + bv[bj][1];
                    if (do_rope) { f32x4 p0, p1;
#pragma unroll
                        for (int e = 0; e < 4; ++e) { p0[e] = __shfl_xor(v0[e], 16); p1[e] = __shfl_xor(v1[e], 16); }
                        v0 = v0 * c0 + p0 * s0; v1 = v1 * c1 + p1 * s1; }
                    const int cl = (col0 & 255) + bj * 128;
                    if (kind == 0) { v0 = v0 * QSCALE; v1 = v1 * QSCALE; st16(Q + (size_t)r * DM + colt + cl, pack8(v0, v1)); }
                    else { bf16_t* dst = (kind == 1 ? K : V) + (size_t)r * 256 + cl; st16(dst, pack8(v0, v1));
                        if (tk) { *(f32x4*)(tk + cl) = v0; *(f32x4*)(tk + cl + 4) = v1; } } } }
    }
};

struct ResidOrder { pg8::StaticOrder so; int S, ntk;
    __device__ void init(int G, int c, int S_, int ntk_) { so.init(MP, DM, G, c); S = S_; ntk = ntk_; }
    __device__ bool next(int i, Unit& u) const {
        if (so.G == so.nwg) {
            const bool has_split = so.c < 16 * S;
            if (has_split && i == 0) { const int t16 = so.c / S, ks = so.c % S; u.pm = MP / 256 + (t16 >> 2); u.pn = t16 & 3; u.k0 = ks * ntk; u.nt = ntk; return true; }
            if (i == (has_split ? 1 : 0)) return so.next(0, u);
            return false; }
        const long L = (long)i * so.G + so.c;
        if (L < so.nwg) return so.next(i, u);
        const int s = (int)(L - so.nwg); if (s >= 16 * S) return false;
        const int t16 = s / S, ks = s % S; u.pm = MP / 256 + (t16 >> 2); u.pn = t16 & 3; u.k0 = ks * ntk; u.nt = ntk; return true;
    }
    __device__ __forceinline__ void a_ready(const Unit&) const {}
    __device__ __forceinline__ void done(const Unit&) const {}
};
__device__ __forceinline__ unsigned f2bf(float f) { unsigned u = __builtin_bit_cast(unsigned, f); return (u + 0x7fffu + ((u >> 16) & 1u)) >> 16; }
__device__ __forceinline__ unsigned pk2(float lo, float hi) { return f2bf(lo) | (f2bf(hi) << 16); }
struct TItem { const float* src; bf16_t* dst; int K, N; };
__device__ __forceinline__ void titem_load(const TItem& t, f32x4 (&v)[8], int lane) {
#pragma unroll
    for (int i = 0; i < 8; ++i) v[i] = *(const f32x4*)(t.src + (size_t)(4 * i + (lane >> 4)) * t.N + (lane & 15) * 4);
}
__device__ __forceinline__ void titem_store(const TItem& t, const f32x4 (&v)[8], LAS float* scr, int lane) {
#pragma unroll
    for (int i = 0; i < 8; ++i) { LAS float* s = scr + (4 * i + (lane >> 4)) * 65 + (lane & 15) * 4; s[0] = v[i][0]; s[1] = v[i][1]; s[2] = v[i][2]; s[3] = v[i][3]; }
    asm volatile("s_waitcnt lgkmcnt(0)" ::: "memory");
#pragma unroll
    for (int j = 0; j < 4; ++j) { const int id = lane + 64 * j, n = id >> 2, c = id & 3; const LAS float* s = scr + (8 * c) * 65 + n;
        u32x4 o; o.x = pk2(s[0 * 65], s[1 * 65]); o.y = pk2(s[2 * 65], s[3 * 65]); o.z = pk2(s[4 * 65], s[5 * 65]); o.w = pk2(s[6 * 65], s[7 * 65]);
        *(u32x4*)(t.dst + (size_t)n * t.K + 8 * c) = o; }
    asm volatile("s_waitcnt lgkmcnt(0)" ::: "memory");
}
__device__ __forceinline__ void prologue_phase(PPtr P, LAS unsigned char* lds, int gw, int NGW, int lane, int wave) {
    LAS float* scr = (LAS float*)(lds + wave * 16384);
    unsigned char* ws = P->ws;
    constexpr int NMAT = 7;
    const int   mi[NMAT] = {I_WADA, I_WQKV, I_WO, I_WSI, I_WSO, I_WUP, I_WDN};
    const int   mk[NMAT] = {DM, DM, DM, DM, DSGU, DM, DFF};
    const int   mn[NMAT] = {6144, QKVN, DM, 2 * DSGU, DM, DFF2, DM};
    const int   ml[NMAT] = {4, 2, 2, 2, 2, 4, 4};
    const size_t mo[NMAT] = {WS_R1, WS_WQKV, WS_WO, WS_WSI, WS_WSO, WS_WUP, WS_WDN};
    int total = 0;
#pragma unroll
    for (int i = 0; i < NMAT; ++i) total += ml[i] * (mk[i] / 32) * (mn[i] / 64);
#define TITEM_DECODE(it_, T_) do { int r_ = (it_); \
        _Pragma("unroll") for (int i = 0; i < NMAT; ++i) { const int per = (mk[i] / 32) * (mn[i] / 64), cnt = ml[i] * per; \
            if (r_ >= 0 && r_ < cnt) { const int l_ = r_ / per, li_ = r_ % per, nblk = mn[i] / 64, kb = li_ / nblk, nb = li_ % nblk; const size_t mat = (size_t)mk[i] * mn[i]; \
                T_.src = P->in[mi[i]] + (size_t)l_ * mat + (size_t)(32 * kb) * mn[i] + 64 * nb; T_.dst = (bf16_t*)(ws + mo[i]) + (size_t)l_ * mat + (size_t)(64 * nb) * mk[i] + 32 * kb; T_.K = mk[i]; T_.N = mn[i]; r_ = -1; } \
            else if (r_ >= 0) r_ -= cnt; } } while (0)
    for (int it = gw; it < total; it += 2 * NGW) {
        TItem ta, tb; f32x4 va[8], vb[8]; const bool two = it + NGW < total;
        TITEM_DECODE(it, ta); titem_load(ta, va, lane);
        if (two) { TITEM_DECODE(it + NGW, tb); titem_load(tb, vb, lane); }
        titem_store(ta, va, scr, lane);
        if (two) titem_store(tb, vb, scr, lane);
    }
#undef TITEM_DECODE
    const int gt = gw * 64 + lane, NGT = NGW * 64;
    float* rope = (float*)(ws + WS_ROPE);
    for (int i = gt; i < NPOS * 8; i += NGT) { const int pos = i >> 3, k = i & 7; const double rev = (double)pos * P->inv[k] * 0.15915494309189535; const float fr = (float)(rev - floor(rev));
        rope[pos * 16 + k] = __builtin_amdgcn_cosf(fr); rope[pos * 16 + 8 + k] = __builtin_amdgcn_sinf(fr); }
    float* rst = (float*)(ws + WS_RSTAT);
    for (int i = gt; i < 2 * M * 2; i += NGT) rst[i] = 0.f;
    bf16_t* wtri = (bf16_t*)(ws + WS_WTRI);
    for (int i = gt; i < 2 * 4 * 2 * 16384; i += NGT) { const int s = i & 127, t = (i >> 7) & 127, var = (i >> 14) & 1, lg = i >> 15; const float* w = P->in[I_WSP] + (size_t)lg * 16384; float v;
        if (var == 0) v = s <= t ? w[t * 128 + s] : 0.f; else v = ((s >> 3) == (t >> 3) && (s & 7) <= (t & 7)) ? w[(t & 7) * 128 + (s & 7)] : 0.f;
        wtri[i] = (bf16_t)f2bf(v); }
    bf16_t* SC = (bf16_t*)(ws + WS_SC);
    for (int i = gt; i < 256 * DM; i += NGT) { const int s = i >> 10, k = i & 1023; float v = 0.f;
        if (s < NSEQ) { const float c = s < 2 ? P->in[I_CP][s * DM + k] : P->in[I_CS][(s - 2) * DM + k]; v = c / (1.0f + __expf(-c)); }
        SC[i] = (bf16_t)f2bf(v); }
}
__device__ __forceinline__ void norm_phase(PPtr P, int l, int mode, bool first, int nsplit, int gw, int NGW, int lane) {
    float* xbuf = P->out; bf16_t* XN = (bf16_t*)(P->ws + WS_R2); const float* mod = (const float*)(P->ws + WS_MOD);
    const float* gw_ = mode == 2 ? P->in[I_NFIN] : (mode == 0 ? P->in[I_NMIX] : P->in[I_NFFN]) + l * DM;
    f32x4 g[4];
#pragma unroll
    for (int j = 0; j < 4; ++j) g[j] = ((const f32x4*)gw_)[lane + 64 * j];
    for (int r = MP + gw; r < M; r += NGW) {
        const float* src = first ? P->in[I_XS] + (size_t)(r - MP) * DM : xbuf + (size_t)r * DM;
        f32x4 v[4], shs[4], scs[4];
#pragma unroll
        for (int j = 0; j < 4; ++j) v[j] = ((const f32x4*)src)[lane + 64 * j];
        if (mode != 2) { int seq, t; row_info(r, seq, t); const float* mr = mod + (size_t)seq * MODW + l * 6144 + (mode ? 3 * DM : 0);
#pragma unroll
            for (int j = 0; j < 4; ++j) { shs[j] = ((const f32x4*)mr)[lane + 64 * j]; scs[j] = ((const f32x4*)(mr + DM))[lane + 64 * j]; } }
        if (nsplit > 0) { const float* pp = (const float*)(P->ws + WS_PART) + (size_t)(r - MP) * DM;
#pragma unroll
            for (int bt = 0; bt < 4; ++bt) { f32x4 pv[3][4];
#pragma unroll
                for (int s = 0; s < 3; ++s) if (bt * 3 + s < nsplit) {
#pragma unroll
                    for (int j = 0; j < 4; ++j) pv[s][j] = ((const f32x4*)(pp + (size_t)(bt * 3 + s) * MS * DM))[lane + 64 * j]; }
#pragma unroll
                for (int s = 0; s < 3; ++s) if (bt * 3 + s < nsplit) {
#pragma unroll
                    for (int j = 0; j < 4; ++j) v[j] += pv[s][j]; }
                asm volatile("" ::: "memory"); } }
        float ss = 0.f;
#pragma unroll
        for (int j = 0; j < 4; ++j) ss += (v[j][0] * v[j][0] + v[j][1] * v[j][1]) + (v[j][2] * v[j][2] + v[j][3] * v[j][3]);
        const float rs = 1.0f / sqrtf(wave_sum(ss) * (1.0f / DM) + EPS);
        if (mode == 2) {
#pragma unroll
            for (int j = 0; j < 4; ++j) ((f32x4*)(xbuf + (size_t)r * DM))[lane + 64 * j] = v[j] * rs * g[j];
        } else {
#pragma unroll
            for (int j = 0; j < 4; ++j) { const f32x4 sh = shs[j], sc = scs[j];
                const f32x4 h = v[j] * rs * g[j] * (sc + 1.0f) + sh; u32x2 w; w.x = cvt_pk_bf16(h[0], h[1]); w.y = cvt_pk_bf16(h[2], h[3]);
                st8((u32x2*)(XN + (size_t)r * DM) + lane + 64 * j, w);
                if (first || nsplit > 0) ((f32x4*)(xbuf + (size_t)r * DM))[lane + 64 * j] = v[j]; } }
    }
    int base = gw, stride = NGW, nk = (MP - gw + NGW - 1) / NGW;
    if (NGW == 2 * MS && MP == 8 * NGW) { stride = MS; if (gw < MS) { base = gw; nk = 6; } else { base = 6 * MS + (gw - MS); nk = 10; } }
    for (int k = 0; k < nk; k += 2) {
        const int r0 = base + stride * k, r1 = r0 + stride; const bool has1 = k + 1 < nk;
        f32x4 v[2][4], sh[2][4], sc[2][4];
#pragma unroll
        for (int q = 0; q < 2; ++q) { const int r = q ? r1 : r0; if (q == 0 || has1) {
            const float* src = first ? P->in[I_XP] + (size_t)r * DM : xbuf + (size_t)r * DM;
#pragma unroll
            for (int j = 0; j < 4; ++j) v[q][j] = ((const f32x4*)src)[lane + 64 * j];
            if (mode != 2) { const float* mr = mod + (size_t)(r >> 13) * MODW + l * 6144 + (mode ? 3 * DM : 0);
#pragma unroll
                for (int j = 0; j < 4; ++j) { sh[q][j] = ((const f32x4*)mr)[lane + 64 * j]; sc[q][j] = ((const f32x4*)(mr + DM))[lane + 64 * j]; } } } }
        float ss[2] = {0.f, 0.f};
#pragma unroll
        for (int q = 0; q < 2; ++q) if (q == 0 || has1) {
#pragma unroll
            for (int j = 0; j < 4; ++j) ss[q] += (v[q][j][0] * v[q][j][0] + v[q][j][1] * v[q][j][1]) + (v[q][j][2] * v[q][j][2] + v[q][j][3] * v[q][j][3]); }
        ss[0] = wave_sum(ss[0]); if (has1) ss[1] = wave_sum(ss[1]);
#pragma unroll
        for (int q = 0; q < 2; ++q) { const int r = q ? r1 : r0; if (q == 0 || has1) {
            const float rs = 1.0f / sqrtf(ss[q] * (1.0f / DM) + EPS);
            if (mode == 2) {
#pragma unroll
                for (int j = 0; j < 4; ++j) ((f32x4*)(xbuf + (size_t)r * DM))[lane + 64 * j] = v[q][j] * rs * g[j];
            } else {
#pragma unroll
                for (int j = 0; j < 4; ++j) { const f32x4 h = v[q][j] * rs * g[j] * (sc[q][j] + 1.0f) + sh[q][j]; u32x2 w; w.x = cvt_pk_bf16(h[0], h[1]); w.y = cvt_pk_bf16(h[2], h[3]);
                    st8((u32x2*)(XN + (size_t)r * DM) + lane + 64 * j, w);
                    if (first) ((f32x4*)(xbuf + (size_t)r * DM))[lane + 64 * j] = v[q][j]; }
            } } }
    }
}
__device__ __forceinline__ void ld8bf(const bf16_t* p, f32x4& lo, f32x4& hi) { const u32x4 w = *(const u32x4*)p; lo = (f32x4){bf2f(w.x & 0xffffu), bf2f(w.x >> 16), bf2f(w.y & 0xffffu), bf2f(w.y >> 16)}; hi = (f32x4){bf2f(w.z & 0xffffu), bf2f(w.z >> 16), bf2f(w.w & 0xffffu), bf2f(w.w >> 16)}; }
__device__ __forceinline__ void conv_phase(PPtr P, int l, int gtid, int NGT) {
    const bf16_t* A = (const bf16_t*)(P->ws + WS_R1); bf16_t* HB = (bf16_t*)(P->ws + WS_R2);
    const float* cw = P->in[I_CW] + (size_t)l * 3 * DFF2; const float* cb = P->in[I_CB] + (size_t)l * DFF2; const float* st = P->in[I_SCONV] + (size_t)l * 128 * 2 * DFF2;
    constexpr int NCG = DFF / 8, NITEM = (M / 16) * NCG;
    for (int it = gtid; it < NITEM; it += NGT) {
        const int seg = it / NCG, c = (it % NCG) * 8, r0 = seg * 16; const bool samp = r0 >= MP;
        f32x4 wg[3][2], wu[3][2], bg[2], bu[2];
#pragma unroll
        for (int h = 0; h < 2; ++h) {
#pragma unroll
            for (int j = 0; j < 3; ++j) { wg[j][h] = *(const f32x4*)(cw + j * DFF2 + c + 4 * h); wu[j][h] = *(const f32x4*)(cw + j * DFF2 + DFF + c + 4 * h); }
            bg[h] = *(const f32x4*)(cb + c + 4 * h); bu[h] = *(const f32x4*)(cb + DFF + c + 4 * h); }
        f32x4 g0[2], g1[2], u0[2], u1[2];
        if (!samp) {
            if ((r0 & (SEQ - 1)) == 0) {
#pragma unroll
                for (int h = 0; h < 2; ++h) g0[h] = g1[h] = u0[h] = u1[h] = (f32x4){0.f, 0.f, 0.f, 0.f};
            } else { ld8bf(A + (size_t)(r0 - 2) * DFF2 + c, g0[0], g0[1]); ld8bf(A + (size_t)(r0 - 2) * DFF2 + DFF + c, u0[0], u0[1]); ld8bf(A + (size_t)(r0 - 1) * DFF2 + c, g1[0], g1[1]); ld8bf(A + (size_t)(r0 - 1) * DFF2 + DFF + c, u1[0], u1[1]); }
        }
#pragma unroll
        for (int hb_ = 0; hb_ < 2; ++hb_) {
            u32x4 rg[8], ru[8];
#pragma unroll
            for (int i = 0; i < 8; ++i) { rg[i] = *(const u32x4*)(A + (size_t)(r0 + hb_ * 8 + i) * DFF2 + c); ru[i] = *(const u32x4*)(A + (size_t)(r0 + hb_ * 8 + i) * DFF2 + DFF + c); }
            if (samp) { const float* s = st + (size_t)((r0 - MP + hb_ * 8) >> 3) * 2 * DFF2 + c;
#pragma unroll
                for (int h = 0; h < 2; ++h) { g0[h] = *(const f32x4*)(s + 4 * h); u0[h] = *(const f32x4*)(s + DFF + 4 * h); g1[h] = *(const f32x4*)(s + DFF2 + 4 * h); u1[h] = *(const f32x4*)(s + DFF2 + DFF + 4 * h); } }
#pragma unroll
            for (int i = 0; i < 8; ++i) { f32x4 g2[2], u2[2], hh[2];
                g2[0] = (f32x4){bf2f(rg[i].x & 0xffffu), bf2f(rg[i].x >> 16), bf2f(rg[i].y & 0xffffu), bf2f(rg[i].y >> 16)}; g2[1] = (f32x4){bf2f(rg[i].z & 0xffffu), bf2f(rg[i].z >> 16), bf2f(rg[i].w & 0xffffu), bf2f(rg[i].w >> 16)};
                u2[0] = (f32x4){bf2f(ru[i].x & 0xffffu), bf2f(ru[i].x >> 16), bf2f(ru[i].y & 0xffffu), bf2f(ru[i].y >> 16)}; u2[1] = (f32x4){bf2f(ru[i].z & 0xffffu), bf2f(ru[i].z >> 16), bf2f(ru[i].w & 0xffffu), bf2f(ru[i].w >> 16)};
#pragma unroll
                for (int h = 0; h < 2; ++h) { const f32x4 cg_ = wg[0][h] * g0[h] + wg[1][h] * g1[h] + wg[2][h] * g2[h] + bg[h], cu = wu[0][h] * u0[h] + wu[1][h] * u1[h] + wu[2][h] * u2[h] + bu[h];
#pragma unroll
                    for (int e = 0; e < 4; ++e) hh[h][e] = cg_[e] * __builtin_amdgcn_rcpf(1.0f + __builtin_amdgcn_exp2f(-cg_[e] * LOG2E)) * cu[e];
                    g0[h] = g1[h]; g1[h] = g2[h]; u0[h] = u1[h]; u1[h] = u2[h]; }
                st16(HB + (size_t)(r0 + hb_ * 8 + i) * DFF + c, pack8(hh[0], hh[1])); }
        }
    }
}

constexpr int KPITCH = 144  , VPITCH = 544  , ATT_K = 0, ATT_V = 256 * KPITCH;
typedef unsigned long long u64;
__device__ __forceinline__ void attn16(const LAS unsigned char* Kl, const LAS unsigned char* Vt, const bf16x8 (&qf)[2], bf16_t* optr, int qi, int jmin, float sink2, int kw0, int fr, int fq) {
    f32x4 s[10];
#pragma unroll
    for (int kt = 0; kt < 10; ++kt) { s[kt] = (f32x4){0.f, 0.f, 0.f, 0.f};
#pragma unroll
        for (int kk = 0; kk < 2; ++kk) { const bf16x8 kf = *(const LAS bf16x8*)(Kl + (kw0 + 16 * kt + fr) * KPITCH + (32 * kk + 8 * fq) * 2); s[kt] = __builtin_amdgcn_mfma_f32_16x16x32_bf16(kf, qf[kk], s[kt], 0, 0, 0); } }
    const int lo = qi > jmin ? qi : jmin, hi = qi + 128; float mx = sink2;
#pragma unroll
    for (int kt = 0; kt < 10; ++kt)
#pragma unroll
        for (int i = 0; i < 4; ++i) { const int j = kw0 + 16 * kt + 4 * fq + i; const float v = (j >= lo && j <= hi) ? s[kt][i] : -INFINITY; s[kt][i] = v; mx = fmaxf(mx, v); }
    mx = fmaxf(mx, __shfl_xor(mx, 16)); mx = fmaxf(mx, __shfl_xor(mx, 32));
    float sum = 0.f;
#pragma unroll
    for (int kt = 0; kt < 10; ++kt)
#pragma unroll
        for (int i = 0; i < 4; ++i) { const float p = __builtin_amdgcn_exp2f(s[kt][i] - mx); s[kt][i] = p; sum += p; }
    sum += __shfl_xor(sum, 16); sum += __shfl_xor(sum, 32); sum += __builtin_amdgcn_exp2f(sink2 - mx);
    const float inv = 1.0f / sum;
    f32x4 o[4];
#pragma unroll
    for (int dt = 0; dt < 4; ++dt) o[dt] = (f32x4){0.f, 0.f, 0.f, 0.f};
#pragma unroll
    for (int sl = 0; sl < 5; ++sl) { const u32x4 pw = pack8(s[2 * sl], s[2 * sl + 1]); const bf16x8 pf = __builtin_bit_cast(bf16x8, pw);
#pragma unroll
        for (int dt = 0; dt < 4; ++dt) { const LAS unsigned char* vp = Vt + (dt * 16 + fr) * VPITCH + (kw0 + 32 * sl + 4 * fq) * 2;
            const u32x2 a = *(const LAS u32x2*)vp, b = *(const LAS u32x2*)(vp + 32); const u32x4 vw = {a.x, a.y, b.x, b.y};
            o[dt] = __builtin_amdgcn_mfma_f32_16x16x32_bf16(__builtin_bit_cast(bf16x8, vw), pf, o[dt], 0, 0, 0); } }
#pragma unroll
    for (int dt = 0; dt < 4; ++dt) { u32x2 w; w.x = cvt_pk_bf16(o[dt][0] * inv, o[dt][1] * inv); w.y = cvt_pk_bf16(o[dt][2] * inv, o[dt][3] * inv); *(u32x2*)(optr + dt * 16 + 4 * fq) = w; }
}
__device__ __forceinline__ void attn_phase(PPtr P, int la, LAS unsigned char* lds, int vcu, int G, int tid, int wave, int lane) {
    const bf16_t* Q = (const bf16_t*)(P->ws + WS_R1); const bf16_t* K = (const bf16_t*)(P->ws + WS_R1 + 34 * MiB); const bf16_t* V = (const bf16_t*)(P->ws + WS_R1 + 43 * MiB); bf16_t* O = (bf16_t*)(P->ws + WS_R1 + 52 * MiB);
    const float* sink = P->in[I_SINK] + la * 16; const int fr = lane & 15, fq = lane >> 4;
    LAS unsigned char* Kl = lds + ATT_K; LAS unsigned char* Vt = lds + ATT_V;
    const float* ck = P->in[I_CK] + (size_t)la * 128 * 128 * 256; const float* cv = P->in[I_CV] + (size_t)la * 128 * 128 * 256;
    float* oks = P->out + O_KS + (size_t)la * 128 * 128 * 256; float* ovs = P->out + O_VS + (size_t)la * 128 * 128 * 256;
#define VT_SCATTER(part_, j_, vv_) do { _Pragma("unroll") for (int e = 0; e < 4; ++e) { *(LAS unsigned short*)(Vt + ((part_) * 8 + 2 * e) * VPITCH + (j_) * 2) = (unsigned short)((vv_)[e] & 0xffffu); *(LAS unsigned short*)(Vt + ((part_) * 8 + 2 * e + 1) * VPITCH + (j_) * 2) = (unsigned short)((vv_)[e] >> 16); } } while (0)
    for (int un = vcu; un < 1024; un += G) {
        if (un < 512) {
            const int b = un >> 8, g = (un >> 6) & 3, qb = un & 63; const int rbase = b * SEQ + qb * 128;
            const int qi = 16 * wave + fr, kw0 = wave < 6 ? 16 * wave : 96, jmin = qb == 0 ? 128 : 0;
            const bf16_t* qrow = Q + (size_t)(rbase + qi) * DM + 4 * g * 64 + 8 * fq;
            bf16x8 qf[2], qn[2];
#pragma unroll
            for (int kk = 0; kk < 2; ++kk) qf[kk] = *(const bf16x8*)(qrow + 32 * kk);
            const f32x4 snk = *(const f32x4*)(sink + 4 * g) * LOG2E;
            u32x4 kv[4], vv[4];
#pragma unroll
            for (int k = 0; k < 4; ++k) { const int ci = tid + 512 * k, j = ci >> 3, part = ci & 7; int row = rbase - 128 + j; if (qb == 0 && j < 128) row = rbase + j;
                kv[k] = *(const u32x4*)(K + (size_t)row * 256 + g * 64 + part * 8); vv[k] = *(const u32x4*)(V + (size_t)row * 256 + g * 64 + part * 8); }
#pragma unroll
            for (int k = 0; k < 4; ++k) { const int ci = tid + 512 * k, j = ci >> 3, part = ci & 7; *(LAS u32x4*)(Kl + j * KPITCH + part * 16) = kv[k]; VT_SCATTER(part, j, vv[k]); }
            __syncthreads();
#pragma unroll
            for (int hh = 0; hh < 4; ++hh) { const int h = 4 * g + hh;
                if (hh < 3) {
#pragma unroll
                    for (int kk = 0; kk < 2; ++kk) qn[kk] = *(const bf16x8*)(qrow + (hh + 1) * 64 + 32 * kk); }
                attn16(Kl, Vt, qf, O + (size_t)(rbase + qi) * DM + h * 64, qi, jmin, snk[hh], kw0, fr, fq);
                qf[0] = qn[0]; qf[1] = qn[1]; }
        } else {
            const int b = (un - 512) >> 2, g = un & 3;
            const int hs = 4 * g + 2 * (wave & 1) + (fr >> 3), ts = fr & 7; const size_t ros = (size_t)(MP + b * 8 + ts) * DM + hs * 64;
            bf16x8 qf[2];
#pragma unroll
            for (int kk = 0; kk < 2; ++kk) qf[kk] = *(const bf16x8*)(Q + ros + 32 * kk + 8 * fq);
            const float snk = sink[hs] * LOG2E;
            f32x4 ck0[2], ck1[2], cv0[2], cv1[2]; u32x4 nk = {0u, 0u, 0u, 0u}, nv = nk;
#pragma unroll
            for (int it = 0; it < 2; ++it) { const int ci = tid + 512 * it, j = ci >> 3, part = ci & 7; const size_t so = ((size_t)(b * 128 + j) * 4 + g) * 64 + part * 8;
                ck0[it] = *(const f32x4*)(ck + so); ck1[it] = *(const f32x4*)(ck + so + 4); cv0[it] = *(const f32x4*)(cv + so); cv1[it] = *(const f32x4*)(cv + so + 4); }
            { const int j = 128 + (tid >> 3), part = tid & 7; if (tid < 256 && j < 136) { const size_t row = MP + b * 8 + (j - 128); nk = *(const u32x4*)(K + row * 256 + g * 64 + part * 8); nv = *(const u32x4*)(V + row * 256 + g * 64 + part * 8); } }
#pragma unroll
            for (int it = 0; it < 2; ++it) { const int ci = tid + 512 * it, j = ci >> 3, part = ci & 7;
                if (j >= 8) { const size_t d = ((size_t)(b * 128 + j - 8) * 4 + g) * 64 + part * 8; *(f32x4*)(oks + d) = ck0[it]; *(f32x4*)(oks + d + 4) = ck1[it]; *(f32x4*)(ovs + d) = cv0[it]; *(f32x4*)(ovs + d + 4) = cv1[it]; }
                *(LAS u32x4*)(Kl + j * KPITCH + part * 16) = pack8(ck0[it], ck1[it]); const u32x4 vvp = pack8(cv0[it], cv1[it]); VT_SCATTER(part, j, vvp); }
            if (tid < 256) { const int j = 128 + (tid >> 3), part = tid & 7; *(LAS u32x4*)(Kl + j * KPITCH + part * 16) = nk; VT_SCATTER(part, j, nv); }
            __syncthreads();
            if (wave < 2) attn16(Kl, Vt, qf, O + ros, ts, 0, snk, 0, fr, fq);
        }
        __syncthreads();
    }
#undef VT_SCATTER
}

constexpr int WPITCH = 272  , MIX_W = 0, MIX_V = 128 * WPITCH;
__device__ __forceinline__ void mix_phase(PPtr P, int ls, LAS unsigned char* lds, int vcu, int G, int tid, int wave, int lane, bool dummy) {
    bf16_t* U = (bf16_t*)(P->ws + WS_R1); const bf16_t* VR = (const bf16_t*)(P->ws + WS_R1 + (size_t)M * DSGU * 2);
    const float* rstat = (const float*)(P->ws + WS_RSTAT) + (size_t)ls * M * 2; const bf16_t* wtri = (const bf16_t*)(P->ws + WS_WTRI) + (size_t)ls * 4 * 2 * 16384;
    const float* lg = P->in[I_LNG] + ls * DSGU; const float* lb = P->in[I_LNB] + ls * DSGU; float* osg = P->out + O_SG + (size_t)ls * MS * DSGU;
    const float* bsp = P->in[I_BSP] + ls * 4 * 128; const int fr = lane & 15, fq = lane >> 4;
    LAS unsigned char* Wl = lds + MIX_W; LAS unsigned char* Vb = lds + MIX_V;
    constexpr int VBUF = 128 * WPITCH, NUN = 136 * 16;
    const int part = tid & 15, sb = tid >> 4;
#define LDS_BAR() do { asm volatile("s_waitcnt lgkmcnt(0)" ::: "memory"); __builtin_amdgcn_s_barrier(); asm volatile("" ::: "memory"); } while (0)
    u32x4 raw[4]; float st0[4], st1[4]; int wvar = -1;
#define MIX_LOAD(un_) do { const int rc_ = (un_) >> 4, colb_ = (((un_) >> 2) & 3) * 512 + ((un_) & 3) * 128 + part * 8; \
        _Pragma("unroll") for (int k = 0; k < 4; ++k) { const int row_ = rc_ * 128 + sb + 32 * k; raw[k] = *(const u32x4*)(VR + (size_t)row_ * DSGU + colb_); st0[k] = rstat[2 * row_]; st1[k] = rstat[2 * row_ + 1]; } } while (0)
#define MIX_FILL(un_, Vl_) do { const int rc_ = (un_) >> 4, c0 = (((un_) >> 2) & 3) * 512 + ((un_) & 3) * 128 + part * 8; const bool samp_ = rc_ >= 128; \
        const f32x4 g0 = *(const f32x4*)(lg + c0), g1 = *(const f32x4*)(lg + c0 + 4), b0 = *(const f32x4*)(lb + c0), b1 = *(const f32x4*)(lb + c0 + 4); \
        _Pragma("unroll") for (int k = 0; k < 4; ++k) { const int s = sb + 32 * k, row = rc_ * 128 + s; const u32x4 w = raw[k]; \
            const f32x4 x0 = {bf2f(w.x & 0xffffu), bf2f(w.x >> 16), bf2f(w.y & 0xffffu), bf2f(w.y >> 16)}, x1 = {bf2f(w.z & 0xffffu), bf2f(w.z >> 16), bf2f(w.w & 0xffffu), bf2f(w.w >> 16)}; \
            const float mu = st0[k] * (1.0f / DSGU), var_ = fmaxf(st1[k] * (1.0f / DSGU) - mu * mu, 0.f), rs = 1.0f / sqrtf(var_ + EPS); \
            const f32x4 y0 = (x0 - mu) * rs * g0 + b0, y1 = (x1 - mu) * rs * g1 + b1; \
            if (samp_) { float* o = osg + (size_t)(row - MP) * DSGU + c0; *(f32x4*)o = y0; *(f32x4*)(o + 4) = y1; } \
            const u32x4 vv = pack8(y0, y1); const int so = ((((s >> 3) ^ part) << 3) + (s & 7)) * 2; \
            _Pragma("unroll") for (int e = 0; e < 4; ++e) { *(LAS unsigned short*)((Vl_) + (part * 8 + 2 * e) * WPITCH + so) = (unsigned short)(vv[e] & 0xffffu); *(LAS unsigned short*)((Vl_) + (part * 8 + 2 * e + 1) * WPITCH + so) = (unsigned short)(vv[e] >> 16); } } } while (0)
    int un = vcu, cur = 0;
    if (un < NUN) { MIX_LOAD(un); MIX_FILL(un, Vb); if (un + G < NUN) MIX_LOAD(un + G); }
    LDS_BAR();
    for (; un < NUN; un += G, cur ^= 1) {
        const int rc = un >> 4, g = (un >> 2) & 3, cs = un & 3; const bool samp = rc >= 128; const int colb = g * 512 + cs * 128;
        LAS unsigned char* Vl = Vb + cur * VBUF;
        const int var = g * 2 + (samp ? 1 : 0);
        if (var != wvar) { wvar = var; const bf16_t* wt = wtri + (size_t)var * 16384;
#pragma unroll
            for (int k = 0; k < 4; ++k) { const int ci = tid + 512 * k, t = ci >> 4, q = ci & 15; *(LAS u32x4*)(Wl + t * WPITCH + q * 16) = *(const u32x4*)(wt + t * 128 + q * 8); }
            LDS_BAR(); }
        u32x2 uws[8]; float bss[8];
#pragma unroll
        for (int tt = 0; tt < 8; ++tt) { const int t = tt * 16 + fr; uws[tt] = *(const u32x2*)(U + (size_t)(rc * 128 + t) * DSGU + colb + wave * 16 + 4 * fq); bss[tt] = bsp[g * 128 + (samp ? (t & 7) : t)]; }
        if (un + G < NUN) { MIX_FILL(un + G, Vb + (cur ^ 1) * VBUF); if (un + 2 * G < NUN) MIX_LOAD(un + 2 * G); }
        bf16x8 vf[4];
#pragma unroll
        for (int ks = 0; ks < 4; ++ks) vf[ks] = *(const LAS bf16x8*)(Vl + (wave * 16 + fr) * WPITCH + (((4 * ks + fq) ^ (wave * 2 + (fr >> 3))) << 4));
#pragma unroll
        for (int tt = 0; tt < 8; ++tt) { f32x4 acc = {0.f, 0.f, 0.f, 0.f};
#pragma unroll
            for (int ks = 0; ks < 4; ++ks) if (ks <= tt / 2) { const bf16x8 wf = *(const LAS bf16x8*)(Wl + (tt * 16 + fr) * WPITCH + (32 * ks + 8 * fq) * 2); acc = __builtin_amdgcn_mfma_f32_16x16x32_bf16(vf[ks], wf, acc, 0, 0, 0); }
            const int t = tt * 16 + fr; const float bias = bss[tt];
            bf16_t* up = U + (size_t)(rc * 128 + t) * DSGU + colb + wave * 16 + 4 * fq; const u32x2 uw = uws[tt];
            u32x2 w; w.x = cvt_pk_bf16(bf2f(uw.x & 0xffffu) * (acc[0] + bias), bf2f(uw.x >> 16) * (acc[1] + bias)); w.y = cvt_pk_bf16(bf2f(uw.y & 0xffffu) * (acc[2] + bias), bf2f(uw.y >> 16) * (acc[3] + bias));
            *(u32x2*)(dummy ? up + (size_t)68 * MiB : up) = w; }
        LDS_BAR();
    }
#undef MIX_LOAD
#undef MIX_FILL
#undef LDS_BAR
}

#define XB_TMO      128
#define XB_XCNT(j)  (256  + 64 * (j))
#define XB_XSUB(j)  (1280 + 64 * (j))
#define XB_XGEN(j)  (2304 + 64 * (j))
#define XB_TOP      3328
#define XB_TOPGEN   3392
#define XCD_BAR_WORDS 3456
#define XB_SPIN_CAP (1u << 18)

__device__ __forceinline__ unsigned xb_ld(unsigned* p)              { return __hip_atomic_load(p, __ATOMIC_RELAXED, __HIP_MEMORY_SCOPE_AGENT); }
__device__ __forceinline__ unsigned xb_add(unsigned* p, unsigned v) { return __hip_atomic_fetch_add(p, v, __ATOMIC_RELAXED, __HIP_MEMORY_SCOPE_AGENT); }
__device__ __forceinline__ unsigned xb_xcc_id() { return (unsigned)__builtin_amdgcn_s_getreg((3 << 11) | 20) & 0xFu; }
#define XB_SPIN(cond, bar) do { unsigned _sp = 0; while (cond) { __builtin_amdgcn_s_sleep(1); \
    if ((++_sp & 255u) == 0u) { if (xb_ld(&(bar)[XB_TMO])) break; if (_sp > XB_SPIN_CAP) { atomicAdd(&(bar)[XB_TMO], 1u); break; } } } } while (0)

struct XcdBarrier {
    unsigned* bar; unsigned x;
    volatile LAS unsigned* st;
};

__device__ __forceinline__ XcdBarrier xcd_barrier_post(unsigned* bar, volatile LAS unsigned* st) {
    XcdBarrier b; b.bar = bar; b.x = xb_xcc_id(); b.st = st;
    if (threadIdx.x == 0) (void)xb_add(&bar[XB_XCNT(b.x)], 1u);
    return b;
}
__device__ __forceinline__ void xcd_barrier_complete(unsigned* bar, unsigned x, unsigned& nloc, unsigned& nx) {
    const unsigned G = gridDim.x * gridDim.y * gridDim.z;
    unsigned sum, cnt, mine, sp = 0u;
    for (;;) {
        sum = 0u; cnt = 0u; mine = 0u;
#pragma unroll
        for (unsigned j = 0; j < 16; ++j) { const unsigned c = xb_ld(&bar[XB_XCNT(j)]); sum += c; cnt += (c > 0u) ? 1u : 0u; mine = (j == x) ? c : mine; }
        if (sum == G) break;
        __builtin_amdgcn_s_sleep(1);
        if ((++sp & 255u) == 0u) { if (xb_ld(&bar[XB_TMO])) break; if (sp > XB_SPIN_CAP) { atomicAdd(&bar[XB_TMO], 1u); break; } }
    }
    nloc = mine > 0u ? mine : 1u; nx = cnt > 0u ? cnt : 1u;
}

__device__ __forceinline__ void xcd_barrier(const XcdBarrier& b) {
    asm volatile("s_waitcnt vmcnt(0)" ::: "memory");
    __syncthreads();
    if (threadIdx.x == 0) {
        unsigned* bar = b.bar;
        __builtin_amdgcn_s_waitcnt(0);
        unsigned nloc = b.st[0], nx = b.st[1];
        if (nloc == 0u) { xcd_barrier_complete(bar, b.x, nloc, nx); b.st[0] = nloc; b.st[1] = nx; }
        const unsigned old = xb_add(&bar[XB_XSUB(b.x)], 1u);
        const unsigned gen = old / nloc;
        if (old + 1u == (gen + 1u) * nloc) {
            __builtin_amdgcn_fence(__ATOMIC_RELEASE, "agent");
            asm volatile("s_waitcnt vmcnt(0)" ::: "memory");
            const unsigned og = xb_add(&bar[XB_TOP], 1u);
            const unsigned tg = og / nx;
            if (og + 1u == (tg + 1u) * nx) xb_add(&bar[XB_TOPGEN], 1u);
            else XB_SPIN(xb_ld(&bar[XB_TOPGEN]) == tg, bar);
            __builtin_amdgcn_fence(__ATOMIC_ACQUIRE, "agent");
            xb_add(&bar[XB_XGEN(b.x)], 1u);
            asm volatile("s_waitcnt vmcnt(0)" ::: "memory");
        } else {
            XB_SPIN(xb_ld(&bar[XB_XGEN(b.x)]) == gen, bar);
            __builtin_amdgcn_fence(__ATOMIC_ACQUIRE, "agent");
            asm volatile("s_waitcnt vmcnt(0)" ::: "memory");
        }
    }
    __syncthreads();
}

#ifndef DBG_REP_KIND
#define DBG_REP_KIND -1
#endif
#ifndef DBG_REP_N
#define DBG_REP_N 1
#endif
#ifndef DBG_SYNC_N
#define DBG_SYNC_N 1
#endif
#ifndef DBG_MASK
#define DBG_MASK 0xffff
#endif
#define DM_(k) ((DBG_MASK >> (k)) & 1)
constexpr int N_PHASES = 39;
__device__ __forceinline__ bool phase_active(int ph) { if (ph < 2 || ph == 38) return true; const int l = (ph - 2) / 9, k = (ph - 2) % 9; return !(((l & 1) == 0 && k == 3) || ((l & 1) == 1 && k == 2)); }
__global__ void __launch_bounds__(NTHR) fwd_kernel(Params Pval) {
    PPtr P = (PPtr)__builtin_amdgcn_kernarg_segment_ptr();
    extern __shared__ __attribute__((aligned(16))) unsigned char lds_raw[];
    LAS unsigned char* lds = (LAS unsigned char*)lds_raw;
    { int t0 = threadIdx.x; for (int u = t0; u < (LDS_BYTES - 131072) / 4; u += NTHR) ((LAS unsigned*)(lds + 131072))[u] = 0u; }
    __syncthreads();
    const XcdBarrier xbar = xcd_barrier_post((unsigned*)P->ws + 4096, (volatile LAS unsigned*)(lds + 131072 + 320) + 8);
    const int ph_hi = P->ph_hi;
    for (int it = P->ph_lo * DBG_REP_N; it < ph_hi * DBG_REP_N; ++it) {
        const int ph = it / DBG_REP_N;
        if (!phase_active(ph)) continue;
        asm volatile("" : "+s"(P));
        int tid = threadIdx.x; asm volatile("" : "+v"(tid)); const int lane = tid & 63, wave = __builtin_amdgcn_readfirstlane(tid >> 6);
        int G = gridDim.x, bx = blockIdx.x; asm volatile("" : "+s"(G), "+s"(bx)); const int vcu = (G % 8 == 0) ? (bx % 8) * (G / 8) + bx / 8 : bx;
        unsigned char* ws = P->ws; float* mod = (float*)(ws + WS_MOD); const bf16_t* XN = (const bf16_t*)(ws + WS_R2);
        const int gw = vcu * NWAVES + wave, NGW = G * NWAVES;
        int kind, l = 0, li = 0, k = 0;
        if (ph == 0) kind = 0; else if (ph == 1) kind = 1; else if (ph == 38) kind = 2;
        else { l = (ph - 2) / 9; k = (ph - 2) % 9; li = l >> 1; const bool attn = (l & 1) == 0;
            kind = (k == 0 || k == 5) ? 2 : k == 1 ? (attn ? 3 : 6) : k == 2 ? (attn ? 4 : 7) : k == 3 ? 8 : (k == 4 || k == 8) ? 5 : k == 6 ? 9 : 10; }
        if (it % DBG_REP_N != 0 && !(kind == DBG_REP_KIND && ph != 38)) continue;
        if (kind == 0) { if (DM_(0)) prologue_phase(P, lds, gw, NGW, lane, wave); }
        else if (kind == 1) { if (DM_(1)) { pg8::Gemm g{(const bf16_t*)(ws + WS_SC), (const bf16_t*)(ws + WS_R1), 256, MODW, DM}; pg8::StaticOrder S; S.init(256, MODW, G, bx);
            EpiAda E{mod, P->in[I_BADA]}; pg8::gemm_phase<EpiAda, pg8::StaticOrder, true, true>(lds, g, S, E); } }
        else if (kind == 2) { if (DM_(2)) norm_phase(P, l, ph == 38 ? 2 : (k == 5 ? 1 : 0), ph == 2, ph == 2 ? 0 : (ph == 38 || k == 0) ? 11 : 8, gw, NGW, lane); }
        else if (kind == 3) { if (DM_(3)) { pg8::Gemm g{XN, (const bf16_t*)(ws + WS_WQKV) + (size_t)li * QKVN * DM, M, QKVN, DM}; pg8::StaticOrder S; S.init(M, QKVN, G, bx);
            EpiQKV E{(bf16_t*)(ws + WS_R1), (bf16_t*)(ws + WS_R1 + 34 * MiB), (bf16_t*)(ws + WS_R1 + 43 * MiB), P->in[I_BQKV] + li * QKVN, (const float*)(ws + WS_ROPE),
                     P->out + O_KP + (size_t)li * 65536, P->out + O_VP + (size_t)li * 65536, P->out + O_KS + (size_t)li * 4194304, P->out + O_VS + (size_t)li * 4194304};
            pg8::gemm_phase<EpiQKV, pg8::StaticOrder, true, true>(lds, g, S, E); } }
        else if (kind == 4) { if (DM_(4)) attn_phase(P, li, lds, vcu, G, tid, wave, lane); }
        else if (kind == 5) { if (DM_(5)) {
            const bf16_t* A; const bf16_t* Bt; int K; int part = 2;
            if (k == 8) { A = (const bf16_t*)(ws + WS_R2); Bt = (const bf16_t*)(ws + WS_WDN) + (size_t)l * DM * DFF; K = DFF; part = 5; }
            else if ((l & 1) == 0) { A = (const bf16_t*)(ws + WS_R1 + 52 * MiB); Bt = (const bf16_t*)(ws + WS_WO) + (size_t)li * DM * DM; K = DM; }
            else { A = (const bf16_t*)(ws + WS_R1); Bt = (const bf16_t*)(ws + WS_WSO) + (size_t)li * DM * DSGU; K = DSGU; }
            const int ns = K == DFF ? 11 : 8, ntk = K / 64 / ns;
            pg8::Gemm g{A, Bt, M, DM, K}; ResidOrder S; S.init(G, bx, ns, ntk);
            EpiResid E{P->out, mod + l * 6144 + part * DM, (float*)(ws + WS_PART), ntk, (DBG_REP_KIND == 5 && DBG_REP_N > 1 && it % DBG_REP_N == 0) ? 0.f : 1.f}; pg8::gemm_phase<EpiResid, ResidOrder, true, true>(lds, g, S, E); } }
        else if (kind == 6) { if (DM_(6)) { pg8::Gemm g{XN, (const bf16_t*)(ws + WS_WSI) + (size_t)li * 2 * DSGU * DM, M, 2 * DSGU, DM}; pg8::StaticOrder S; S.init(M, 2 * DSGU, G, bx);
            EpiGelu E{(bf16_t*)(ws + WS_R1), (bf16_t*)(ws + WS_R1 + (size_t)M * DSGU * 2), P->in[I_BSI] + li * 2 * DSGU, (float*)(ws + WS_RSTAT) + (size_t)li * M * 2}; pg8::gemm_phase<EpiGelu, pg8::StaticOrder, true, true>(lds, g, S, E); } }
        else if (kind == 8) { if (DM_(8)) mix_phase(P, li, lds, vcu, G, tid, wave, lane, DBG_REP_KIND == 8 && DBG_REP_N > 1 && it % DBG_REP_N == 0); }
        else if (kind == 9) { if (DM_(9)) { pg8::Gemm g{XN, (const bf16_t*)(ws + WS_WUP) + (size_t)l * DFF2 * DM, M, DFF2, DM}; pg8::StaticOrder S; S.init(M, DFF2, G, bx);
            EpiUp E{(bf16_t*)(ws + WS_R1), P->out + O_CP + (size_t)l * 2 * 2 * DFF2, P->out + O_CS + (size_t)l * 128 * 2 * DFF2}; pg8::gemm_phase<EpiUp, pg8::StaticOrder, true, true>(lds, g, S, E); } }
        else { if (DM_(10)) conv_phase(P, l, bx * NTHR + tid, G * NTHR); }
        if (it + 1 < ph_hi * DBG_REP_N) { for (int sr = 0; sr < DBG_SYNC_N; ++sr) { if (ph_hi < 0) { __syncthreads(); cg::this_grid().sync(); } else xcd_barrier(xbar); } }
    }
}

extern "C" void kernel_launch(void* const* d_in, const int* in_sizes, int n_in, void* d_out, int out_size, void* d_ws, size_t ws_size, hipStream_t stream) {
    static int grid = 0;
    if (grid == 0) {
        if (n_in != 27 || (size_t)out_size != O_END || ws_size < WS_END) { fprintf(stderr, "kernel_launch: unexpected shapes: n_in %d out %d ws %zu\n", n_in, out_size, ws_size); grid = -1; return; }
        int dev = 0, cus = 0, per_cu = 0;
        hipGetDevice(&dev); hipDeviceGetAttribute(&cus, hipDeviceAttributeMultiprocessorCount, dev);
        if (hipFuncSetAttribute((const void*)fwd_kernel, hipFuncAttributeMaxDynamicSharedMemorySize, LDS_BYTES) != hipSuccess) { fprintf(stderr, "kernel_launch: hipFuncSetAttribute failed\n"); grid = -1; return; }
        if (hipOccupancyMaxActiveBlocksPerMultiprocessor(&per_cu, (const void*)fwd_kernel, NTHR, LDS_BYTES) != hipSuccess || per_cu < 1) { fprintf(stderr, "kernel_launch: occupancy query says %d\n", per_cu); (void)hipGetLastError(); grid = -1; return; }
        grid = cus;
    }
    if (grid < 0) return;
    Params p; memset(&p, 0, sizeof(p));
    for (int i = 0; i < 27; ++i) p.in[i] = (const float*)d_in[i];
    p.out = (float*)d_out; p.ws = (unsigned char*)d_ws;
    for (int i = 0; i < 8; ++i) p.inv[i] = pow(500000.0, -(double)i / 8.0);
#if MK_PER_PHASE
    for (int ph = 0; ph < N_PHASES; ++ph) { bool act = (ph < 2 || ph == 38) || !((((ph - 2) / 9) & 1) == 0 && (ph - 2) % 9 == 3); if (!act) continue;
        p.ph_lo = ph; p.ph_hi = ph + 1; hipLaunchKernelGGL(fwd_kernel, dim3(grid), dim3(NTHR), LDS_BYTES, stream, p); }
#else
    if (hipMemsetAsync(d_ws, 0, 65536, stream) != hipSuccess) { fprintf(stderr, "kernel_launch: memset failed\n"); return; }
    p.ph_lo = 0; p.ph_hi = N_PHASES; void* args[] = {&p};
    hipError_t e = hipLaunchCooperativeKernel((const void*)fwd_kernel, dim3(grid), dim3(NTHR), args, LDS_BYTES, stream);
    if (e != hipSuccess) fprintf(stderr, "kernel_launch: cooperative launch failed: %s (grid %d)\n", hipGetErrorString(e), grid);
#endif
}
```

```cpp
#include <hip/hip_runtime.h>
#include <hip/hip_cooperative_groups.h>
#include <cstdio>
#include <cstdint>
#include <cstring>
#include <cmath>
namespace cg = cooperative_groups;
namespace pg8 {
#define PG8_LAS __attribute__((address_space(3)))
typedef unsigned short bf16_t;
typedef short bf16x8 __attribute__((ext_vector_type(8)));
typedef float f32x4 __attribute__((ext_vector_type(4)));
typedef unsigned u32x4 __attribute__((ext_vector_type(4)));
constexpr int BM = 256, BK = 64, HALF = 128, HTB = HALF * BK * 2  , STAGE_BYTES = 8 * HTB, NXCD = 8, WGM = 8;

__host__ __device__ __forceinline__ int lds_byte(int r, int c) { const int st = (r >> 4) * 2 + (c >> 5), rr = r & 15, cc = c & 31, ob = rr * 64 + cc * 2; return st * 1024 + (ob ^ (((ob >> 9) & 1) << 5)); }
__host__ __device__ __forceinline__ void stage_rc(int b, int& R, int& C) { const int st = b / 1024, sb = b % 1024, swz = sb ^ (((sb >> 9) & 1) << 5); R = (st >> 1) * 16 + swz / 64; C = (st & 1) * 32 + (swz % 64) / 2; }
__host__ __device__ __forceinline__ int perm32(int rho) { const int n = rho >> 4, i = rho & 15; return 8 * (i >> 2) + 4 * n + (i & 3); }

struct Unit { int pm, pn, k0, nt; };
struct Gemm { const bf16_t* A; const bf16_t* Bt; int M, N, K; };

struct StaticOrder {
    int nM, nN, nwg, G, c;
    __host__ __device__ void init(int M, int N, int G_, int c_) { nM = M / BM; nN = N / BM; nwg = nM * nN; G = G_; c = c_; }
    __host__ __device__ bool next(int i, Unit& u) const {
        const long L = (long)i * G + c; if (L >= nwg) return false;
        int wgid = (int)L; { const int q = nwg / NXCD, r = nwg % NXCD, xcd = wgid % NXCD, off = wgid / NXCD; wgid = (xcd < r ? xcd * (q + 1) : r * (q + 1) + (xcd - r) * q) + off; }
        const int nig = WGM * nN, gid = wgid / nig, fm = gid * WGM, gsz = (nM - fm) < WGM ? (nM - fm) : WGM;
        u.pm = fm + ((wgid % nig) % gsz); u.pn = (wgid % nig) / gsz; u.k0 = 0; u.nt = 0; return true;
    }
    __device__ __forceinline__ void a_ready(const Unit&) const {}
    __device__ __forceinline__ void done(const Unit&) const {}
};

__device__ __forceinline__ unsigned cvt_pk_bf16(float lo, float hi) { unsigned r; asm volatile("v_cvt_pk_bf16_f32 %0, %1, %2" : "=v"(r) : "v"(lo), "v"(hi)); return r; }
typedef float f32x2 __attribute__((ext_vector_type(2)));
template <class Epi, class Sched, bool ALIGN_EPI = false, bool SP2 = false>
__device__ __forceinline__ void gemm_phase(PG8_LAS unsigned char* lds, const Gemm g, const Sched& S, const Epi& E) {
    int tid_ = threadIdx.x; asm volatile("" : "+v"(tid_));
    const int tid = tid_, wid = __builtin_amdgcn_readfirstlane(tid >> 6), lane = tid & 63, wr = wid >> 2, wc = wid & 3, fr = lane & 15, fq = lane >> 4;
    const int K = g.K, nt = K / BK;
    unsigned voffA[2], voffB[2];
#pragma unroll
    for (int i = 0; i < 2; ++i) { int R, C; stage_rc(tid * 16 + i * 8192, R, C); const int Rb = Epi::PERM ? ((R & ~31) + perm32(R & 31)) : R;
        voffA[i] = (unsigned)(R * K + C) * 2u; voffB[i] = (unsigned)(Rb * K + C) * 2u; }
    const size_t kstep = (size_t)(BK * 2);
    const size_t hstep = (size_t)HALF * K * 2;
    const size_t tstep = 2 * hstep;
    const unsigned ldsw = (unsigned)wid * 1024u;
    const int aoff = lds_byte(wr * 64 + fr, fq * 8), boff = lds_byte(wc * 32 + fr, fq * 8);
#define PG8_SA(b, h) (((b) * 2 + (h)) * HTB)
#define PG8_SB(b, h) ((4 + (b) * 2 + (h)) * HTB)
#define PG8_STAGE(bufoff, gbase, voff) do { _Pragma("unroll") for (int _i = 0; _i < 2; ++_i) \
        __builtin_amdgcn_global_load_lds((const unsigned*)((const char*)(gbase) + (voff)[_i]), (PG8_LAS unsigned*)(lds + (bufoff) + ldsw + _i * 8192), 16, 0, 0); } while (0)
#define PG8_LDA(dst, b, h) do { _Pragma("unroll") for (int m = 0; m < 4; ++m) _Pragma("unroll") for (int k = 0; k < 2; ++k) dst[m][k] = *(const PG8_LAS bf16x8*)(lds + PG8_SA(b, h) + aoff + m * 2048 + k * 1024); } while (0)
#define PG8_LDB(dst, b, h) do { _Pragma("unroll") for (int n = 0; n < 2; ++n) _Pragma("unroll") for (int k = 0; k < 2; ++k) dst[n][k] = *(const PG8_LAS bf16x8*)(lds + PG8_SB(b, h) + boff + n * 2048 + k * 1024); } while (0)
#define PG8_MMA(ai, bj, At, Bt) do { __builtin_amdgcn_s_setprio(1); _Pragma("unroll") for (int m = 0; m < 4; ++m) _Pragma("unroll") for (int n = 0; n < 2; ++n) _Pragma("unroll") for (int k = 0; k < 2; ++k) \
        acc[ai][bj][m][n] = __builtin_amdgcn_mfma_f32_16x16x32_bf16(Bt[n][k], At[m][k], acc[ai][bj][m][n], 0, 0, 0); __builtin_amdgcn_s_setprio(0); } while (0)
#define PG8_WAIT_V(n) asm volatile("s_waitcnt vmcnt(" #n ")" ::: "memory")
#define PG8_WAIT_L(n) asm volatile("s_waitcnt lgkmcnt(" #n ")" ::: "memory")
#define PG8_BAR __builtin_amdgcn_s_barrier()
#define PG8_SCHED __builtin_amdgcn_sched_barrier(0)
    Unit cur, nxt; int ui = 0;
    if (!S.next(0, cur)) return;
    f32x4 acc[2][2][4][2];
#pragma unroll
    for (int a = 0; a < 2; ++a)
#pragma unroll
        for (int b = 0; b < 2; ++b)
#pragma unroll
            for (int m = 0; m < 4; ++m)
#pragma unroll
                for (int n = 0; n < 2; ++n) acc[a][b][m][n] = (f32x4){0.f, 0.f, 0.f, 0.f};
    if constexpr (Epi::HAS_INIT) E.init(acc, cur, wr, wc, fr, fq);
    bf16x8 At[4][2], B0[2][2], B1[2][2];
    const char* cA = (const char*)g.A + (size_t)cur.pm * tstep + (size_t)cur.k0 * kstep; const char* cB = (const char*)g.Bt + (size_t)cur.pn * tstep + (size_t)cur.k0 * kstep;
    S.a_ready(cur);
    if constexpr (SP2) {
        PG8_STAGE(PG8_SB(0, 0), cB, voffB); PG8_STAGE(PG8_SB(0, 1), cB + hstep, voffB); PG8_STAGE(PG8_SA(0, 0), cA, voffA); PG8_STAGE(PG8_SA(0, 1), cA + hstep, voffA);
        if (wr == 1) PG8_BAR;
        PG8_WAIT_V(2); PG8_BAR;
        PG8_STAGE(PG8_SB(1, 0), cB + kstep, voffB); PG8_STAGE(PG8_SA(1, 0), cA + kstep, voffA); PG8_STAGE(PG8_SB(1, 1), cB + hstep + kstep, voffB);
        PG8_WAIT_V(6); PG8_BAR;
    } else {
        PG8_STAGE(PG8_SB(0, 0), cB, voffB); PG8_STAGE(PG8_SA(0, 0), cA, voffA); PG8_STAGE(PG8_SB(0, 1), cB + hstep, voffB); PG8_STAGE(PG8_SA(0, 1), cA + hstep, voffA);
        if (wr == 1) PG8_BAR;
        PG8_WAIT_V(4); PG8_BAR;
        PG8_STAGE(PG8_SB(1, 0), cB + kstep, voffB); PG8_STAGE(PG8_SA(1, 0), cA + kstep, voffA); PG8_STAGE(PG8_SB(1, 1), cB + hstep + kstep, voffB);
        PG8_WAIT_V(6); PG8_BAR;
    }
    for (;;) {
        const bool has_next = S.next(ui + 1, nxt);
        const char* nA = has_next ? (const char*)g.A + (size_t)nxt.pm * tstep + (size_t)nxt.k0 * kstep : cA; const char* nB = has_next ? (const char*)g.Bt + (size_t)nxt.pn * tstep + (size_t)nxt.k0 * kstep : cB;
        const int cnt = cur.nt ? cur.nt : nt;
        for (int t = 0; t < cnt; t += 2) {
            const bool last = (t == cnt - 2);
            const char* a1 = cA + (size_t)(t + 1) * kstep;
            const char* a2 = last ? nA : cA + (size_t)(t + 2) * kstep; const char* b2 = last ? nB : cB + (size_t)(t + 2) * kstep;
            const char* a3 = a2 + kstep; const char* b3 = b2 + kstep;
            if (last && has_next) S.a_ready(nxt);
            if constexpr (SP2) {
            PG8_LDB(B0, 0, 0); PG8_LDB(B1, 0, 1); PG8_SCHED; PG8_LDA(At, 0, 0); PG8_STAGE(PG8_SA(1, 1), a1 + hstep, voffA);
            PG8_WAIT_V(8); PG8_WAIT_L(0); PG8_BAR; PG8_MMA(0, 0, At, B0); PG8_MMA(0, 1, At, B1); PG8_BAR; PG8_SCHED;
            PG8_LDA(At, 0, 1); PG8_STAGE(PG8_SB(0, 0), b2, voffB); PG8_STAGE(PG8_SB(0, 1), b2 + hstep, voffB); PG8_STAGE(PG8_SA(0, 0), a2, voffA);
            PG8_WAIT_V(8); PG8_WAIT_L(0); PG8_BAR; PG8_MMA(1, 0, At, B0); PG8_MMA(1, 1, At, B1); PG8_BAR; PG8_SCHED;
            PG8_LDB(B0, 1, 0); PG8_LDB(B1, 1, 1); PG8_SCHED; PG8_LDA(At, 1, 0); PG8_STAGE(PG8_SA(0, 1), a2 + hstep, voffA);
            PG8_WAIT_V(8); PG8_WAIT_L(0); PG8_BAR; PG8_MMA(0, 0, At, B0); PG8_MMA(0, 1, At, B1); PG8_BAR; PG8_SCHED;
            PG8_LDA(At, 1, 1); PG8_STAGE(PG8_SB(1, 0), b3, voffB); PG8_STAGE(PG8_SB(1, 1), b3 + hstep, voffB); PG8_STAGE(PG8_SA(1, 0), a3, voffA);
            PG8_WAIT_V(8); PG8_WAIT_L(0); PG8_BAR; PG8_MMA(1, 0, At, B0); PG8_MMA(1, 1, At, B1); PG8_BAR; PG8_SCHED;
            } else {
            PG8_LDB(B0, 0, 0); PG8_SCHED; PG8_LDA(At, 0, 0); PG8_STAGE(PG8_SA(1, 1), a1 + hstep, voffA);
            PG8_WAIT_L(8); PG8_BAR; PG8_WAIT_L(0); PG8_MMA(0, 0, At, B0); PG8_BAR; PG8_SCHED;
            PG8_LDB(B1, 0, 1); PG8_STAGE(PG8_SB(0, 0), b2, voffB);
            PG8_BAR; PG8_WAIT_L(0); PG8_MMA(0, 1, At, B1); PG8_BAR;
            PG8_LDA(At, 0, 1); PG8_STAGE(PG8_SA(0, 0), a2, voffA);
            PG8_BAR; PG8_WAIT_L(0); PG8_MMA(1, 0, At, B0); PG8_BAR; PG8_SCHED;
            PG8_STAGE(PG8_SB(0, 1), b2 + hstep, voffB);
            PG8_WAIT_V(6); PG8_BAR; PG8_MMA(1, 1, At, B1); PG8_BAR;
            PG8_LDB(B0, 1, 0); PG8_SCHED; PG8_LDA(At, 1, 0); PG8_STAGE(PG8_SA(0, 1), a2 + hstep, voffA);
            PG8_WAIT_L(8); PG8_BAR; PG8_WAIT_L(0); PG8_MMA(0, 0, At, B0); PG8_BAR; PG8_SCHED;
            PG8_LDB(B1, 1, 1); PG8_STAGE(PG8_SB(1, 0), b3, voffB);
            PG8_BAR; PG8_WAIT_L(0); PG8_MMA(0, 1, At, B1); PG8_BAR;
            PG8_LDA(At, 1, 1); PG8_STAGE(PG8_SA(1, 0), a3, voffA);
            PG8_BAR; PG8_WAIT_L(0); PG8_MMA(1, 0, At, B0); PG8_BAR; PG8_SCHED;
            PG8_STAGE(PG8_SB(1, 1), b3 + hstep, voffB);
            PG8_WAIT_V(6); PG8_BAR; PG8_MMA(1, 1, At, B1); PG8_BAR;
            }
        }
        if constexpr (ALIGN_EPI) { if (wr == 0) PG8_BAR; }
        if constexpr (!Epi::AFTER_DRAIN) { E(acc, cur, wr, wc, fr, fq); S.done(cur); }
        if (!has_next) break;
#pragma unroll
        for (int a = 0; a < 2; ++a)
#pragma unroll
            for (int b = 0; b < 2; ++b)
#pragma unroll
                for (int m = 0; m < 4; ++m)
#pragma unroll
                    for (int n = 0; n < 2; ++n) acc[a][b][m][n] = (f32x4){0.f, 0.f, 0.f, 0.f};
        cur = nxt; cA = nA; cB = nB; ++ui;
        if constexpr (Epi::HAS_INIT) E.init(acc, cur, wr, wc, fr, fq);
        if constexpr (ALIGN_EPI) { if (wr == 1) PG8_BAR; }
    }
    PG8_WAIT_V(0);
    if constexpr (!ALIGN_EPI) { if (wr == 0) PG8_BAR; }
    PG8_BAR;
    if constexpr (Epi::AFTER_DRAIN) { E.fused(acc, cur, wr, wc, fr, fq, lds, wid, lane); S.done(cur); }
#undef PG8_SA
#undef PG8_SB
#undef PG8_STAGE
#undef PG8_LDA
#undef PG8_LDB
#undef PG8_MMA
#undef PG8_WAIT_V
#undef PG8_WAIT_L
#undef PG8_BAR
#undef PG8_SCHED
}
}

#ifndef MK_PER_PHASE
#define MK_PER_PHASE 0
#endif
using pg8::bf16_t; using pg8::bf16x8; using pg8::f32x4; using pg8::u32x4; using pg8::cvt_pk_bf16; using pg8::Unit;
#ifndef LAS
#define LAS __attribute__((address_space(3)))
#endif
typedef unsigned u32x2 __attribute__((ext_vector_type(2)));
constexpr int DM = 1024, MP = 16384, MS = 1024, M = MP + MS, SEQ = 8192, NSEQ = 130, DEPTH = 4;
constexpr int DFF = 2816, DFF2 = 5632, DSGU = 2048, QKVN = 1536, MODW = 6144 * DEPTH, NPOS = 8200;
constexpr float EPS = 1e-6f, LOG2E = 1.4426950408889634f, QSCALE = 0.125f * LOG2E;
constexpr int NWAVES = 8, NTHR = 512;
constexpr size_t O_Y = 0, O_KP = (size_t)M * DM, O_VP = O_KP + 131072, O_CP = O_VP + 131072, O_KS = O_CP + 90112,
                 O_VS = O_KS + 8388608, O_CS = O_VS + 8388608, O_SG = O_CS + 5767168, O_END = O_SG + 4194304;
constexpr size_t MiB = 1u << 20;
constexpr size_t WS_RSTAT = 128 * 1024  , WS_WTRI = 2 * MiB + 512 * 1024  ;
constexpr size_t WS_ROPE = 1 * MiB, WS_SC = 2 * MiB, WS_MOD = 3 * MiB, WS_WQKV = 16 * MiB, WS_WO = 22 * MiB, WS_WSI = 26 * MiB, WS_WSO = 42 * MiB,
                 WS_WUP = 50 * MiB, WS_WDN = 94 * MiB, WS_R2 = 116 * MiB, WS_R1 = 210 * MiB, WS_END = 397 * MiB;
constexpr size_t WS_PART = WS_R1 + 140 * MiB;
static_assert(WS_PART + 11 * (size_t)MS * DM * 4 <= WS_END, "partials");
static_assert(WS_R2 + (size_t)M * DFF * 2 <= WS_R1 && WS_R1 + (size_t)M * DFF2 * 2 <= WS_END && WS_MOD + (size_t)NSEQ * MODW * 4 <= WS_WQKV, "ws map");
constexpr int LDS_BYTES = 147456;

struct Params { const float* in[27]; float* out; unsigned char* ws; double inv[8]; int ph_lo, ph_hi; };
#define CAS __attribute__((address_space(4)))
typedef const CAS Params* PPtr;
enum { I_XP = 0, I_XS, I_CP, I_CS, I_CK, I_CV, I_SCONV, I_WADA, I_BADA, I_NMIX, I_NFFN, I_WQKV, I_BQKV, I_SINK, I_WO, I_WSI, I_BSI, I_LNG, I_LNB,
       I_WSP, I_BSP, I_WSO, I_WUP, I_CW, I_CB, I_WDN, I_NFIN };

__device__ __forceinline__ void row_info(int r, int& seq, int& t) { if (r < MP) { seq = r >> 13; t = r & 8191; } else { const int q = r - MP; seq = 2 + (q >> 3); t = q & 7; } }
__device__ __forceinline__ float wave_sum(float v) {
#pragma unroll
    for (int o = 1; o < 64; o <<= 1) v += __shfl_xor(v, o);
    return v;
}
__device__ __forceinline__ float bf2f(unsigned h) { return __uint_as_float(h << 16); }
__device__ __forceinline__ u32x4 pack8(const f32x4 a, const f32x4 b) { u32x4 w; w.x = cvt_pk_bf16(a[0], a[1]); w.y = cvt_pk_bf16(a[2], a[3]); w.z = cvt_pk_bf16(b[0], b[1]); w.w = cvt_pk_bf16(b[2], b[3]); return w; }

#ifndef NT_STORES
#define NT_STORES 0
#endif
__device__ __forceinline__ void st16(void* p, u32x4 v) { if (NT_STORES) __builtin_nontemporal_store(v, (u32x4*)p); else *(u32x4*)p = v; }
__device__ __forceinline__ void st8(void* p, u32x2 v) { if (NT_STORES) __builtin_nontemporal_store(v, (u32x2*)p); else *(u32x2*)p = v; }
struct EpiAda { static constexpr bool PERM = true, AFTER_DRAIN = false, HAS_INIT = false; float* mod; const float* bias;
    __device__ __forceinline__ void operator()(const f32x4 (&acc)[2][2][4][2], const Unit& u, int wr, int wc, int fr, int fq) const {
        const int row0 = u.pm * 256 + wr * 64 + fr, col0 = u.pn * 256 + wc * 32 + 8 * fq;
        f32x4 bv[2][2];
#pragma unroll
        for (int bj = 0; bj < 2; ++bj)
#pragma unroll
            for (int n = 0; n < 2; ++n) bv[bj][n] = *(const f32x4*)(bias + col0 + bj * 128 + 4 * n);
#pragma unroll
        for (int ai = 0; ai < 2; ++ai)
#pragma unroll
            for (int m = 0; m < 4; ++m) { const int r = row0 + ai * 128 + m * 16; if (r < NSEQ) {
#pragma unroll
                for (int bj = 0; bj < 2; ++bj) { float* d = mod + (size_t)r * MODW + col0 + bj * 128;
                    *(f32x4*)d = acc[ai][bj][m][0] + bv[bj][0]; *(f32x4*)(d + 4) = acc[ai][bj][m][1] + bv[bj][1]; } } }
    }
};
__device__ __forceinline__ f32x4 gate_safe(f32x4 g) { f32x4 r;
#pragma unroll
    for (int e = 0; e < 4; ++e) r[e] = __builtin_copysignf(fmaxf(fabsf(g[e]), 1e-30f), g[e]);
    return r; }
struct EpiResid { static constexpr bool PERM = false, AFTER_DRAIN = false, HAS_INIT = false;     float* x; const float* xin; const float* gate; float* part; int ntk; float gscale;
    __device__ __forceinline__ void init(f32x4 (&acc)[2][2][4][2], const Unit& u, int wr, int wc, int fr, int fq) const {
        if (u.nt) return;
        const int row0 = u.pm * 256 + wr * 64 + fr, col0 = u.pn * 256 + wc * 32 + 4 * fq;
#pragma unroll
        for (int ai = 0; ai < 2; ++ai)
#pragma unroll
            for (int m = 0; m < 4; ++m) { const int r = row0 + ai * 128 + m * 16; int seq, t; row_info(r, seq, t);
                const float* xr = x + (size_t)r * DM + col0; const float* gr = gate + (size_t)seq * MODW + col0;
#pragma unroll
                for (int bj = 0; bj < 2; ++bj)
#pragma unroll
                    for (int n = 0; n < 2; ++n) { const int o = bj * 128 + 16 * n; const f32x4 xv = *(const f32x4*)(xr + o), gv = gate_safe(*(const f32x4*)(gr + o));
#pragma unroll
                        for (int e = 0; e < 4; ++e) acc[ai][bj][m][n][e] = xv[e] * __builtin_amdgcn_rcpf(gv[e]); } }
    }
    __device__ __forceinline__ void operator()(const f32x4 (&acc)[2][2][4][2], const Unit& u, int wr, int wc, int fr, int fq) const {
        const int row0 = u.pm * 256 + wr * 64 + fr, col0 = u.pn * 256 + wc * 32 + 4 * fq;
        if (u.nt) {
#pragma unroll
            for (int ai = 0; ai < 2; ++ai) { f32x4 gq[4][2][2];
#pragma unroll
                for (int m = 0; m < 4; ++m) { const int r = row0 + ai * 128 + m * 16; int seq, t; row_info(r, seq, t); const float* gr = gate + (size_t)seq * MODW + col0;
#pragma unroll
                    for (int bj = 0; bj < 2; ++bj)
#pragma unroll
                        for (int n = 0; n < 2; ++n) gq[m][bj][n] = *(const f32x4*)(gr + bj * 128 + 16 * n); }
#pragma unroll
                for (int m = 0; m < 4; ++m) { const int r = row0 + ai * 128 + m * 16; float* pr = part + ((size_t)(u.k0 / ntk) * MS + (r - MP)) * DM + col0;
#pragma unroll
                    for (int bj = 0; bj < 2; ++bj)
#pragma unroll
                        for (int n = 0; n < 2; ++n) *(f32x4*)(pr + bj * 128 + 16 * n) = gq[m][bj][n] * gscale * acc[ai][bj][m][n]; }
                asm volatile("" ::: "memory"); }
        } else {
            int seq0, t0; row_info(u.pm * 256, seq0, t0); const float* gr = gate + (size_t)seq0 * MODW + col0;
            f32x4 gv[2][2];
#pragma unroll
            for (int bj = 0; bj < 2; ++bj)
#pragma unroll
                for (int n = 0; n < 2; ++n) gv[bj][n] = *(const f32x4*)(gr + bj * 128 + 16 * n) * gscale;
#pragma unroll
            for (int ai = 0; ai < 2; ++ai) { f32x4 xv[4][2][2];
#pragma unroll
                for (int m = 0; m < 4; ++m)
#pragma unroll
                    for (int bj = 0; bj < 2; ++bj)
#pragma unroll
                        for (int n = 0; n < 2; ++n) xv[m][bj][n] = *(const f32x4*)(xin + (size_t)(row0 + ai * 128 + m * 16) * DM + col0 + bj * 128 + 16 * n);
#pragma unroll
                for (int m = 0; m < 4; ++m)
#pragma unroll
                    for (int bj = 0; bj < 2; ++bj)
#pragma unroll
                        for (int n = 0; n < 2; ++n) *(f32x4*)(x + (size_t)(row0 + ai * 128 + m * 16) * DM + col0 + bj * 128 + 16 * n) = xv[m][bj][n] + gv[bj][n] * acc[ai][bj][m][n];
                asm volatile("" ::: "memory"); }
        }
    }
};
__device__ __forceinline__ float gelu_tanh(float x) { const float y = x * (1.0f + 0.044715f * x * x) * (1.5957691216057308f * LOG2E); return x * __builtin_amdgcn_rcpf(1.0f + __builtin_amdgcn_exp2f(-y)); }
struct EpiGelu { static constexpr bool PERM = true, AFTER_DRAIN = false, HAS_INIT = false; bf16_t* U; bf16_t* V; const float* bias; float* rstat;
    __device__ __forceinline__ void operator()(const f32x4 (&acc)[2][2][4][2], const Unit& u, int wr, int wc, int fr, int fq) const {
        const int row0 = u.pm * 256 + wr * 64 + fr, colt = u.pn * 256, col0 = colt + wc * 32 + 8 * fq;
        bf16_t* base = (colt < DSGU ? U : V) + ((col0) & (DSGU - 1));
        f32x4 bv[2][2];
#pragma unroll
        for (int bj = 0; bj < 2; ++bj)
#pragma unroll
            for (int n = 0; n < 2; ++n) bv[bj][n] = *(const f32x4*)(bias + col0 + bj * 128 + 4 * n);
#pragma unroll
        for (int ai = 0; ai < 2; ++ai)
#pragma unroll
            for (int m = 0; m < 4; ++m) { const int r = row0 + ai * 128 + m * 16; float s1 = 0.f, s2 = 0.f;
#pragma unroll
                for (int bj = 0; bj < 2; ++bj) { f32x4 v0 = acc[ai][bj][m][0] + bv[bj][0], v1 = acc[ai][bj][m][1] + bv[bj][1];
#pragma unroll
                    for (int e = 0; e < 4; ++e) { v0[e] = gelu_tanh(v0[e]); v1[e] = gelu_tanh(v1[e]); s1 += v0[e] + v1[e]; s2 += v0[e] * v0[e] + v1[e] * v1[e]; }
                    st16(base + (size_t)r * DSGU + bj * 128, pack8(v0, v1)); }
                if (colt >= DSGU) { s1 += __shfl_xor(s1, 16); s2 += __shfl_xor(s2, 16); s1 += __shfl_xor(s1, 32); s2 += __shfl_xor(s2, 32);
                    if (fq == 0) { unsafeAtomicAdd(rstat + 2 * r, s1); unsafeAtomicAdd(rstat + 2 * r + 1, s2); } } }
    }
};
struct EpiUp { static constexpr bool PERM = true, AFTER_DRAIN = false, HAS_INIT = false; bf16_t* a; float* ocp; float* ocs;
    __device__ __forceinline__ void operator()(const f32x4 (&acc)[2][2][4][2], const Unit& u, int wr, int wc, int fr, int fq) const {
        const int row0 = u.pm * 256 + wr * 64 + fr, col0 = u.pn * 256 + wc * 32 + 8 * fq;
#pragma unroll
        for (int ai = 0; ai < 2; ++ai)
#pragma unroll
            for (int m = 0; m < 4; ++m) { const int r = row0 + ai * 128 + m * 16; int seq, t; row_info(r, seq, t);
                float* tail = nullptr;
                if (r < MP) { if (t >= SEQ - 2) tail = ocp + (size_t)(seq * 2 + (t - (SEQ - 2))) * DFF2; }
                else if (t >= 6) tail = ocs + (size_t)((seq - 2) * 2 + (t - 6)) * DFF2;
#pragma unroll
                for (int bj = 0; bj < 2; ++bj) { const int c = col0 + bj * 128;
                    st16(a + (size_t)r * DFF2 + c, pack8(acc[ai][bj][m][0], acc[ai][bj][m][1]));
                    if (tail) { *(f32x4*)(tail + c) = acc[ai][bj][m][0]; *(f32x4*)(tail + c + 4) = acc[ai][bj][m][1]; } } }
    }
};
struct EpiQKV { static constexpr bool PERM = true, AFTER_DRAIN = false, HAS_INIT = false; bf16_t *Q, *K, *V; const float* bias; const float* rope; float *okp, *ovp, *oks, *ovs;
    __device__ __forceinline__ void operator()(const f32x4 (&acc)[2][2][4][2], const Unit& u, int wr, int wc, int fr, int fq) const {
        const int row0 = u.pm * 256 + wr * 64 + fr, colt = u.pn * 256, col0 = colt + wc * 32 + 8 * fq;
        const int kind = colt < 1024 ? 0 : (colt < 1280 ? 1 : 2);
        const bool do_rope = kind < 2 && (wc & 1) == 0;
        const float sgn = fq == 0 ? -1.f : 1.f;
        f32x4 bv[2][2];
#pragma unroll
        for (int bj = 0; bj < 2; ++bj)
#pragma unroll
            for (int n = 0; n < 2; ++n) bv[bj][n] = *(const f32x4*)(bias + col0 + bj * 128 + 4 * n);
        f32x4 rc0[2], rc1[2], rs0[2], rs1[2];
#pragma unroll
        for (int mm = 0; mm < 2; ++mm) { rc0[mm] = rc1[mm] = (f32x4){1.f, 1.f, 1.f, 1.f}; rs0[mm] = rs1[mm] = (f32x4){0.f, 0.f, 0.f, 0.f}; }
#pragma unroll
        for (int ai = 0; ai < 2; ++ai)
#pragma unroll
            for (int m = 0; m < 4; ++m) { const int r = row0 + ai * 128 + m * 16; int seq, t; row_info(r, seq, t);
                if ((m & 1) == 0 && do_rope && fq < 2) {
#pragma unroll
                    for (int mm = m; mm < m + 2; ++mm) { const int r_ = row0 + ai * 128 + mm * 16; int sq_, t_; row_info(r_, sq_, t_); const float* rp = rope + (size_t)(r_ < MP ? t_ : SEQ + t_) * 16;
                        rc0[mm & 1] = *(const f32x4*)rp; rc1[mm & 1] = *(const f32x4*)(rp + 4); rs0[mm & 1] = *(const f32x4*)(rp + 8) * sgn; rs1[mm & 1] = *(const f32x4*)(rp + 12) * sgn; } }
                const f32x4 c0 = rc0[m & 1], c1 = rc1[m & 1], s0 = rs0[m & 1], s1 = rs1[m & 1];
                float* tk = nullptr;
                if (kind > 0) { float* ob_p = kind == 1 ? okp : ovp; float* ob_s = kind == 1 ? oks : ovs;
                    if (r < MP) { if (t >= SEQ - 128) tk = ob_p + (size_t)(seq * 128 + (t - (SEQ - 128))) * 256; }
                    else tk = ob_s + (size_t)((seq - 2) * 128 + 120 + t) * 256; }
#pragma unroll
                for (int bj = 0; bj < 2; ++bj) { f32x4 v0 = acc[ai][bj][m][0] + bv[bj][0], v1 = acc[ai][bj][m][1] + bv[bj][1];
                    if (do_rope) { f32x4 p0, p1;
#pragma unroll
                        for (int e = 0; e < 4; ++e) { p0[e] = __shfl_xor(v0[e], 16); p1[e] = __shfl_xor(v1[e], 16); }
                        v0 = v0 * c0 + p0 * s0; v1 = v1 * c1 + p1 * s1; }
                    const int cl = (col0 & 255) + bj * 128;
                    if (kind == 0) { v0 = v0 * QSCALE; v1 = v1 * QSCALE; st16(Q + (size_t)r * DM + colt + cl, pack8(v0, v1)); }
                    else { bf16_t* dst = (kind == 1 ? K : V) + (size_t)r * 256 + cl; st16(dst, pack8(v0, v1));
                        if (tk) { *(f32x4*)(tk + cl) = v0; *(f32x4*)(tk + cl + 4) = v1; } } } }
    }
};

struct ResidOrder { pg8::StaticOrder so; int S, ntk;
    __device__ void init(int G, int c, int S_, int ntk_) { so.init(MP, DM, G, c); S = S_; ntk = ntk_; }
    __device__ bool next(int i, Unit& u) const {
        if (so.G == so.nwg) {
            const bool has_split = so.c < 16 * S;
            if (has_split && i == 0) { const int t16 = so.c / S, ks = so.c % S; u.pm = MP / 256 + (t16 >> 2); u.pn = t16 & 3; u.k0 = ks * ntk; u.nt = ntk; return true; }
            if (i == (has_split ? 1 : 0)) return so.next(0, u);
            return false; }
        const long L = (long)i * so.G + so.c;
        if (L < so.nwg) return so.next(i, u);
        const int s = (int)(L - so.nwg); if (s >= 16 * S) return false;
        const int t16 = s / S, ks = s % S; u.pm = MP / 256 + (t16 >> 2); u.pn = t16 & 3; u.k0 = ks * ntk; u.nt = ntk; return true;
    }
    __device__ __forceinline__ void a_ready(const Unit&) const {}
    __device__ __forceinline__ void done(const Unit&) const {}
};
__device__ __forceinline__ unsigned f2bf(float f) { unsigned u = __builtin_bit_cast(unsigned, f); return (u + 0x7fffu + ((u >> 16) & 1u)) >> 16; }
__device__ __forceinline__ unsigned pk2(float lo, float hi) { return f2bf(lo) | (f2bf(hi) << 16); }
struct TItem { const float* src; bf16_t* dst; int K, N; };
__device__ __forceinline__ void titem_load(const TItem& t, f32x4 (&v)[8], int lane) {
#pragma unroll
    for (int i = 0; i < 8; ++i) v[i] = *(const f32x4*)(t.src + (size_t)(4 * i + (lane >> 4)) * t.N + (lane & 15) * 4);
}
__device__ __forceinline__ void titem_store(const TItem& t, const f32x4 (&v)[8], LAS float* scr, int lane) {
#pragma unroll
    for (int i = 0; i < 8; ++i) { LAS float* s = scr + (4 * i + (lane >> 4)) * 65 + (lane & 15) * 4; s[0] = v[i][0]; s[1] = v[i][1]; s[2] = v[i][2]; s[3] = v[i][3]; }
    asm volatile("s_waitcnt lgkmcnt(0)" ::: "memory");
#pragma unroll
    for (int j = 0; j < 4; ++j) { const int id = lane + 64 * j, n = id >> 2, c = id & 3; const LAS float* s = scr + (8 * c) * 65 + n;
        u32x4 o; o.x = pk2(s[0 * 65], s[1 * 65]); o.y = pk2(s[2 * 65], s[3 * 65]); o.z = pk2(s[4 * 65], s[5 * 65]); o.w = pk2(s[6 * 65], s[7 * 65]);
        *(u32x4*)(t.dst + (size_t)n * t.K + 8 * c) = o; }
    asm volatile("s_waitcnt lgkmcnt(0)" ::: "memory");
}
__device__ __forceinline__ void prologue_phase(PPtr P, LAS unsigned char* lds, int gw, int NGW, int lane, int wave) {
    LAS float* scr = (LAS float*)(lds + wave * 16384);
    unsigned char* ws = P->ws;
    constexpr int NMAT = 7;
    const int   mi[NMAT] = {I_WADA, I_WQKV, I_WO, I_WSI, I_WSO, I_WUP, I_WDN};
    const int   mk[NMAT] = {DM, DM, DM, DM, DSGU, DM, DFF};
    const int   mn[NMAT] = {6144, QKVN, DM, 2 * DSGU, DM, DFF2, DM};
    const int   ml[NMAT] = {4, 2, 2, 2, 2, 4, 4};
    const size_t mo[NMAT] = {WS_R1, WS_WQKV, WS_WO, WS_WSI, WS_WSO, WS_WUP, WS_WDN};
    int total = 0;
#pragma unroll
    for (int i = 0; i < NMAT; ++i) total += ml[i] * (mk[i] / 32) * (mn[i] / 64);
#define TITEM_DECODE(it_, T_) do { int r_ = (it_); \
        _Pragma("unroll") for (int i = 0; i < NMAT; ++i) { const int per = (mk[i] / 32) * (mn[i] / 64), cnt = ml[i] * per; \
            if (r_ >= 0 && r_ < cnt) { const int l_ = r_ / per, li_ = r_ % per, nblk = mn[i] / 64, kb = li_ / nblk, nb = li_ % nblk; const size_t mat = (size_t)mk[i] * mn[i]; \
                T_.src = P->in[mi[i]] + (size_t)l_ * mat + (size_t)(32 * kb) * mn[i] + 64 * nb; T_.dst = (bf16_t*)(ws + mo[i]) + (size_t)l_ * mat + (size_t)(64 * nb) * mk[i] + 32 * kb; T_.K = mk[i]; T_.N = mn[i]; r_ = -1; } \
            else if (r_ >= 0) r_ -= cnt; } } while (0)
    for (int it = gw; it < total; it += 2 * NGW) {
        TItem ta, tb; f32x4 va[8], vb[8]; const bool two = it + NGW < total;
        TITEM_DECODE(it, ta); titem_load(ta, va, lane);
        if (two) { TITEM_DECODE(it + NGW, tb); titem_load(tb, vb, lane); }
        titem_store(ta, va, scr, lane);
        if (two) titem_store(tb, vb, scr, lane);
    }
#undef TITEM_DECODE
    const int gt = gw * 64 + lane, NGT = NGW * 64;
    float* rope = (float*)(ws + WS_ROPE);
    for (int i = gt; i < NPOS * 8; i += NGT) { const int pos = i >> 3, k = i & 7; const double rev = (double)pos * P->inv[k] * 0.15915494309189535; const float fr = (float)(rev - floor(rev));
        rope[pos * 16 + k] = __builtin_amdgcn_cosf(fr); rope[pos * 16 + 8 + k] = __builtin_amdgcn_sinf(fr); }
    float* rst = (float*)(ws + WS_RSTAT);
    for (int i = gt; i < 2 * M * 2; i += NGT) rst[i] = 0.f;
    bf16_t* wtri = (bf16_t*)(ws + WS_WTRI);
    for (int i = gt; i < 2 * 4 * 2 * 16384; i += NGT) { const int s = i & 127, t = (i >> 7) & 127, var = (i >> 14) & 1, lg = i >> 15; const float* w = P->in[I_WSP] + (size_t)lg * 16384; float v;
        if (var == 0) v = s <= t ? w[t * 128 + s] : 0.f; else v = ((s >> 3) == (t >> 3) && (s & 7) <= (t & 7)) ? w[(t & 7) * 128 + (s & 7)] : 0.f;
        wtri[i] = (bf16_t)f2bf(v); }
    bf16_t* SC = (bf16_t*)(ws + WS_SC);
    for (int i = gt; i < 256 * DM; i += NGT) { const int s = i >> 10, k = i & 1023; float v = 0.f;
        if (s < NSEQ) { const float c = s < 2 ? P->in[I_CP][s * DM + k] : P->in[I_CS][(s - 2) * DM + k]; v = c / (1.0f + __expf(-c)); }
        SC[i] = (bf16_t)f2bf(v); }
}
__device__ __forceinline__ void norm_phase(PPtr P, int l, int mode, bool first, int nsplit, int gw, int NGW, int lane) {
    float* xbuf = P->out; bf16_t* XN = (bf16_t*)(P->ws + WS_R2); const float* mod = (const float*)(P->ws + WS_MOD);
    const float* gw_ = mode == 2 ? P->in[I_NFIN] : (mode == 0 ? P->in[I_NMIX] : P->in[I_NFFN]) + l * DM;
    f32x4 g[4];
#pragma unroll
    for (int j = 0; j < 4; ++j) g[j] = ((const f32x4*)gw_)[lane + 64 * j];
    for (int r = MP + gw; r < M; r += NGW) {
        const float* src = first ? P->in[I_XS] + (size_t)(r - MP) * DM : xbuf + (size_t)r * DM;
        f32x4 v[4], shs[4], scs[4];
#pragma unroll
        for (int j = 0; j < 4; ++j) v[j] = ((const f32x4*)src)[lane + 64 * j];
        if (mode != 2) { int seq, t; row_info(r, seq, t); const float* mr = mod + (size_t)seq * MODW + l * 6144 + (mode ? 3 * DM : 0);
#pragma unroll
            for (int j = 0; j < 4; ++j) { shs[j] = ((const f32x4*)mr)[lane + 64 * j]; scs[j] = ((const f32x4*)(mr + DM))[lane + 64 * j]; } }
        if (nsplit > 0) { const float* pp = (const float*)(P->ws + WS_PART) + (size_t)(r - MP) * DM;
#pragma unroll
            for (int bt = 0; bt < 4; ++bt) { f32x4 pv[3][4];
#pragma unroll
                for (int s = 0; s < 3; ++s) if (bt * 3 + s < nsplit) {
#pragma unroll
                    for (int j = 0; j < 4; ++j) pv[s][j] = ((const f32x4*)(pp + (size_t)(bt * 3 + s) * MS * DM))[lane + 64 * j]; }
#pragma unroll
                for (int s = 0; s < 3; ++s) if (bt * 3 + s < nsplit) {
#pragma unroll
                    for (int j = 0; j < 4; ++j) v[j] += pv[s][j]; }
                asm volatile("" ::: "memory"); } }
        float ss = 0.f;
#pragma unroll
        for (int j = 0; j < 4; ++j) ss += (v[j][0] * v[j][0] + v[j][1] * v[j][1]) + (v[j][2] * v[j][2] + v[j][3] * v[j][3]);
        const float rs = 1.0f / sqrtf(wave_sum(ss) * (1.0f / DM) + EPS);
        if (mode == 2) {
#pragma unroll
            for (int j = 0; j < 4; ++j) ((f32x4*)(xbuf + (size_t)r * DM))[lane + 64 * j] = v[j] * rs * g[j];
        } else {
#pragma unroll
            for (int j = 0; j < 4; ++j) { const f32x4 sh = shs[j], sc = scs[j];
                const f32x4 h = v[j] * rs * g[j] * (sc + 1.0f) + sh; u32x2 w; w.x = cvt_pk_bf16(h[0], h[1]); w.y = cvt_pk_bf16(h[2], h[3]);
                st8((u32x2*)(XN + (size_t)r * DM) + lane + 64 * j, w);
                if (first || nsplit > 0) ((f32x4*)(xbuf + (size_t)r * DM))[lane + 64 * j] = v[j]; } }
    }
    int base = gw, stride = NGW, nk = (MP - gw + NGW - 1) / NGW;
    if (NGW == 2 * MS && MP == 8 * NGW) { stride = MS; if (gw < MS) { base = gw; nk = 6; } else { base = 6 * MS + (gw - MS); nk = 10; } }
    for (int k = 0; k < nk; k += 2) {
        const int r0 = base + stride * k, r1 = r0 + stride; const bool has1 = k + 1 < nk;
        f32x4 v[2][4], sh[2][4], sc[2][4];
#pragma unroll
        for (int q = 0; q < 2; ++q) { const int r = q ? r1 : r0; if (q == 0 || has1) {
            const float* src = first ? P->in[I_XP] + (size_t)r * DM : xbuf + (size_t)r * DM;
#pragma unroll
            for (int j = 0; j < 4; ++j) v[q][j] = ((const f32x4*)src)[lane + 64 * j];
            if (mode != 2) { const float* mr = mod + (size_t)(r >> 13) * MODW + l * 6144 + (mode ? 3 * DM : 0);
#pragma unroll
                for (int j = 0; j < 4; ++j) { sh[q][j] = ((const f32x4*)mr)[lane + 64 * j]; sc[q][j] = ((const f32x4*)(mr + DM))[lane + 64 * j]; } } } }
        float ss[2] = {0.f, 0.f};
#pragma unroll
        for (int q = 0; q < 2; ++q) if (q == 0 || has1) {
#pragma unroll
            for (int j = 0; j < 4; ++j) ss[q] += (v[q][j][0] * v[q][j][0] + v[q][j][1] * v[q][j][1]) + (v[q][j][2] * v[q][j][2] + v[q][j][3] * v[q][j][3]); }
        ss[0] = wave_sum(ss[0]); if (has1) ss[1] = wave_sum(ss[1]);
#pragma unroll
        for (int q = 0; q < 2; ++q) { const int r = q ? r1 : r0; if (q == 0 || has1) {
            const float rs = 1.0f / sqrtf(ss[q] * (1.0f / DM) + EPS);
            if (mode == 2) {
#pragma unroll
                for (int j = 0; j < 4; ++j) ((f32x4*)(xbuf + (size_t)r * DM))[lane + 64 * j] = v[q][j] * rs * g[j];
            } else {
#pragma unroll
                for (int j = 0; j < 4; ++j) { const f32x4 h = v[q][j] * rs * g[j] * (sc[q][j] + 1.0f) + sh[q][j]; u32x2 w; w.x = cvt_pk_bf16(h[0], h[1]); w.y = cvt_pk_bf16(h[2], h[3]);
                    st8((u32x2*)(XN + (size_t)r * DM) + lane + 64 * j, w);
                    }
            } } }
    }
}
__device__ __forceinline__ void ld8bf(const bf16_t* p, f32x4& lo, f32x4& hi) { const u32x4 w = *(const u32x4*)p; lo = (f32x4){bf2f(w.x & 0xffffu), bf2f(w.x >> 16), bf2f(w.y & 0xffffu), bf2f(w.y >> 16)}; hi = (f32x4){bf2f(w.z & 0xffffu), bf2f(w.z >> 16), bf2f(w.w & 0xffffu), bf2f(w.w >> 16)}; }
__device__ __forceinline__ void conv_phase(PPtr P, int l, int gtid, int NGT) {
    const bf16_t* A = (const bf16_t*)(P->ws + WS_R1); bf16_t* HB = (bf16_t*)(P->ws + WS_R2);
    const float* cw = P->in[I_CW] + (size_t)l * 3 * DFF2; const float* cb = P->in[I_CB] + (size_t)l * DFF2; const float* st = P->in[I_SCONV] + (size_t)l * 128 * 2 * DFF2;
    constexpr int NCG = DFF / 8, NITEM = (M / 16) * NCG;
    for (int it = gtid; it < NITEM; it += NGT) {
        const int seg = it / NCG, c = (it % NCG) * 8, r0 = seg * 16; const bool samp = r0 >= MP;
        f32x4 wg[3][2], wu[3][2], bg[2], bu[2];
#pragma unroll
        for (int h = 0; h < 2; ++h) {
#pragma unroll
            for (int j = 0; j < 3; ++j) { wg[j][h] = *(const f32x4*)(cw + j * DFF2 + c + 4 * h); wu[j][h] = *(const f32x4*)(cw + j * DFF2 + DFF + c + 4 * h); }
            bg[h] = *(const f32x4*)(cb + c + 4 * h); bu[h] = *(const f32x4*)(cb + DFF + c + 4 * h); }
        f32x4 g0[2], g1[2], u0[2], u1[2];
        if (!samp) {
            if ((r0 & (SEQ - 1)) == 0) {
#pragma unroll
                for (int h = 0; h < 2; ++h) g0[h] = g1[h] = u0[h] = u1[h] = (f32x4){0.f, 0.f, 0.f, 0.f};
            } else { ld8bf(A + (size_t)(r0 - 2) * DFF2 + c, g0[0], g0[1]); ld8bf(A + (size_t)(r0 - 2) * DFF2 + DFF + c, u0[0], u0[1]); ld8bf(A + (size_t)(r0 - 1) * DFF2 + c, g1[0], g1[1]); ld8bf(A + (size_t)(r0 - 1) * DFF2 + DFF + c, u1[0], u1[1]); }
        }
#pragma unroll
        for (int hb_ = 0; hb_ < 2; ++hb_) {
            u32x4 rg[8], ru[8];
#pragma unroll
            for (int i = 0; i < 8; ++i) { rg[i] = *(const u32x4*)(A + (size_t)(r0 + hb_ * 8 + i) * DFF2 + c); ru[i] = *(const u32x4*)(A + (size_t)(r0 + hb_ * 8 + i) * DFF2 + DFF + c); }
            if (samp) { const float* s = st + (size_t)((r0 - MP + hb_ * 8) >> 3) * 2 * DFF2 + c;
#pragma unroll
                for (int h = 0; h < 2; ++h) { g0[h] = *(const f32x4*)(s + 4 * h); u0[h] = *(const f32x4*)(s + DFF + 4 * h); g1[h] = *(const f32x4*)(s + DFF2 + 4 * h); u1[h] = *(const f32x4*)(s + DFF2 + DFF + 4 * h); } }
#pragma unroll
            for (int i = 0; i < 8; ++i) { f32x4 g2[2], u2[2], hh[2];
                g2[0] = (f32x4){bf2f(rg[i].x & 0xffffu), bf2f(rg[i].x >> 16), bf2f(rg[i].y & 0xffffu), bf2f(rg[i].y >> 16)}; g2[1] = (f32x4){bf2f(rg[i].z & 0xffffu), bf2f(rg[i].z >> 16), bf2f(rg[i].w & 0xffffu), bf2f(rg[i].w >> 16)};
                u2[0] = (f32x4){bf2f(ru[i].x & 0xffffu), bf2f(ru[i].x >> 16), bf2f(ru[i].y & 0xffffu), bf2f(ru[i].y >> 16)}; u2[1] = (f32x4){bf2f(ru[i].z & 0xffffu), bf2f(ru[i].z >> 16), bf2f(ru[i].w & 0xffffu), bf2f(ru[i].w >> 16)};
#pragma unroll
                for (int h = 0; h < 2; ++h) { const f32x4 cg_ = wg[0][h] * g0[h] + wg[1][h] * g1[h] + wg[2][h] * g2[h] + bg[h], cu = wu[0][h] * u0[h] + wu[1][h] * u1[h] + wu[2][h] * u2[h] + bu[h];
#pragma unroll
                    for (int e = 0; e < 4; ++e) hh[h][e] = cg_[e] * __builtin_amdgcn_rcpf(1.0f + __builtin_amdgcn_exp2f(-cg_[e] * LOG2E)) * cu[e];
                    g0[h] = g1[h]; g1[h] = g2[h]; u0[h] = u1[h]; u1[h] = u2[h]; }
                st16(HB + (size_t)(r0 + hb_ * 8 + i) * DFF + c, pack8(hh[0], hh[1])); }
        }
    }
}

constexpr int KPITCH = 144  , VPITCH = 544  , ATT_K = 0, ATT_V = 256 * KPITCH;
typedef unsigned long long u64;
__device__ __forceinline__ void attn16(const LAS unsigned char* Kl, const LAS unsigned char* Vt, const bf16x8 (&qf)[2], bf16_t* optr, int qi, int jmin, float sink2, int kw0, int fr, int fq) {
    f32x4 s[10];
#pragma unroll
    for (int kt = 0; kt < 10; ++kt) { s[kt] = (f32x4){0.f, 0.f, 0.f, 0.f};
#pragma unroll
        for (int kk = 0; kk < 2; ++kk) { const bf16x8 kf = *(const LAS bf16x8*)(Kl + (kw0 + 16 * kt + fr) * KPITCH + (32 * kk + 8 * fq) * 2); s[kt] = __builtin_amdgcn_mfma_f32_16x16x32_bf16(kf, qf[kk], s[kt], 0, 0, 0); } }
    const int lo = qi > jmin ? qi : jmin, hi = qi + 128; float mx = sink2;
#pragma unroll
    for (int kt = 0; kt < 10; ++kt)
#pragma unroll
        for (int i = 0; i < 4; ++i) { const int j = kw0 + 16 * kt + 4 * fq + i; const float v = (j >= lo && j <= hi) ? s[kt][i] : -INFINITY; s[kt][i] = v; mx = fmaxf(mx, v); }
    mx = fmaxf(mx, __shfl_xor(mx, 16)); mx = fmaxf(mx, __shfl_xor(mx, 32));
    float sum = 0.f;
#pragma unroll
    for (int kt = 0; kt < 10; ++kt)
#pragma unroll
        for (int i = 0; i < 4; ++i) { const float p = __builtin_amdgcn_exp2f(s[kt][i] - mx); s[kt][i] = p; sum += p; }
    sum += __shfl_xor(sum, 16); sum += __shfl_xor(sum, 32); sum += __builtin_amdgcn_exp2f(sink2 - mx);
    const float inv = 1.0f / sum;
    f32x4 o[4];
#pragma unroll
    for (int dt = 0; dt < 4; ++dt) o[dt] = (f32x4){0.f, 0.f, 0.f, 0.f};
#pragma unroll
    for (int sl = 0; sl < 5; ++sl) { const u32x4 pw = pack8(s[2 * sl], s[2 * sl + 1]); const bf16x8 pf = __builtin_bit_cast(bf16x8, pw);
#pragma unroll
        for (int dt = 0; dt < 4; ++dt) { const LAS unsigned char* vp = Vt + (dt * 16 + fr) * VPITCH + (kw0 + 32 * sl + 4 * fq) * 2;
            const u32x2 a = *(const LAS u32x2*)vp, b = *(const LAS u32x2*)(vp + 32); const u32x4 vw = {a.x, a.y, b.x, b.y};
            o[dt] = __builtin_amdgcn_mfma_f32_16x16x32_bf16(__builtin_bit_cast(bf16x8, vw), pf, o[dt], 0, 0, 0); } }
#pragma unroll
    for (int dt = 0; dt < 4; ++dt) { u32x2 w; w.x = cvt_pk_bf16(o[dt][0] * inv, o[dt][1] * inv); w.y = cvt_pk_bf16(o[dt][2] * inv, o[dt][3] * inv); *(u32x2*)(optr + dt * 16 + 4 * fq) = w; }
}
__device__ __forceinline__ void attn_phase(PPtr P, int la, LAS unsigned char* lds, int vcu, int G, int tid, int wave, int lane) {
    const bf16_t* Q = (const bf16_t*)(P->ws + WS_R1); const bf16_t* K = (const bf16_t*)(P->ws + WS_R1 + 34 * MiB); const bf16_t* V = (const bf16_t*)(P->ws + WS_R1 + 43 * MiB); bf16_t* O = (bf16_t*)(P->ws + WS_R1 + 52 * MiB);
    const float* sink = P->in[I_SINK] + la * 16; const int fr = lane & 15, fq = lane >> 4;
    LAS unsigned char* Kl = lds + ATT_K; LAS unsigned char* Vt = lds + ATT_V;
    const float* ck = P->in[I_CK] + (size_t)la * 128 * 128 * 256; const float* cv = P->in[I_CV] + (size_t)la * 128 * 128 * 256;
    float* oks = P->out + O_KS + (size_t)la * 128 * 128 * 256; float* ovs = P->out + O_VS + (size_t)la * 128 * 128 * 256;
#define VT_SCATTER(part_, j_, vv_) do { _Pragma("unroll") for (int e = 0; e < 4; ++e) { *(LAS unsigned short*)(Vt + ((part_) * 8 + 2 * e) * VPITCH + (j_) * 2) = (unsigned short)((vv_)[e] & 0xffffu); *(LAS unsigned short*)(Vt + ((part_) * 8 + 2 * e + 1) * VPITCH + (j_) * 2) = (unsigned short)((vv_)[e] >> 16); } } while (0)
    for (int un = vcu; un < 1024; un += G) {
        if (un < 512) {
            const int b = un >> 8, g = (un >> 6) & 3, qb = un & 63; const int rbase = b * SEQ + qb * 128;
            const int qi = 16 * wave + fr, kw0 = wave < 6 ? 16 * wave : 96, jmin = qb == 0 ? 128 : 0;
            const bf16_t* qrow = Q + (size_t)(rbase + qi) * DM + 4 * g * 64 + 8 * fq;
            bf16x8 qf[2], qn[2];
#pragma unroll
            for (int kk = 0; kk < 2; ++kk) qf[kk] = *(const bf16x8*)(qrow + 32 * kk);
            const f32x4 snk = *(const f32x4*)(sink + 4 * g) * LOG2E;
            u32x4 kv[4], vv[4];
#pragma unroll
            for (int k = 0; k < 4; ++k) { const int ci = tid + 512 * k, j = ci >> 3, part = ci & 7; int row = rbase - 128 + j; if (qb == 0 && j < 128) row = rbase + j;
                kv[k] = *(const u32x4*)(K + (size_t)row * 256 + g * 64 + part * 8); vv[k] = *(const u32x4*)(V + (size_t)row * 256 + g * 64 + part * 8); }
#pragma unroll
            for (int k = 0; k < 4; ++k) { const int ci = tid + 512 * k, j = ci >> 3, part = ci & 7; *(LAS u32x4*)(Kl + j * KPITCH + part * 16) = kv[k]; VT_SCATTER(part, j, vv[k]); }
            __syncthreads();
#pragma unroll
            for (int hh = 0; hh < 4; ++hh) { const int h = 4 * g + hh;
                if (hh < 3) {
#pragma unroll
                    for (int kk = 0; kk < 2; ++kk) qn[kk] = *(const bf16x8*)(qrow + (hh + 1) * 64 + 32 * kk); }
                attn16(Kl, Vt, qf, O + (size_t)(rbase + qi) * DM + h * 64, qi, jmin, snk[hh], kw0, fr, fq);
                qf[0] = qn[0]; qf[1] = qn[1]; }
        } else {
            const int b = (un - 512) >> 2, g = un & 3;
            const int hs = 4 * g + 2 * (wave & 1) + (fr >> 3), ts = fr & 7; const size_t ros = (size_t)(MP + b * 8 + ts) * DM + hs * 64;
            bf16x8 qf[2];
#pragma unroll
            for (int kk = 0; kk < 2; ++kk) qf[kk] = *(const bf16x8*)(Q + ros + 32 * kk + 8 * fq);
            const float snk = sink[hs] * LOG2E;
            f32x4 ck0[2], ck1[2], cv0[2], cv1[2]; u32x4 nk = {0u, 0u, 0u, 0u}, nv = nk;
#pragma unroll
            for (int it = 0; it < 2; ++it) { const int ci = tid + 512 * it, j = ci >> 3, part = ci & 7; const size_t so = ((size_t)(b * 128 + j) * 4 + g) * 64 + part * 8;
                ck0[it] = *(const f32x4*)(ck + so); ck1[it] = *(const f32x4*)(ck + so + 4); cv0[it] = *(const f32x4*)(cv + so); cv1[it] = *(const f32x4*)(cv + so + 4); }
            { const int j = 128 + (tid >> 3), part = tid & 7; if (tid < 256 && j < 136) { const size_t row = MP + b * 8 + (j - 128); nk = *(const u32x4*)(K + row * 256 + g * 64 + part * 8); nv = *(const u32x4*)(V + row * 256 + g * 64 + part * 8); } }
#pragma unroll
            for (int it = 0; it < 2; ++it) { const int ci = tid + 512 * it, j = ci >> 3, part = ci & 7;
                if (j >= 8) { const size_t d = ((size_t)(b * 128 + j - 8) * 4 + g) * 64 + part * 8; *(f32x4*)(oks + d) = ck0[it]; *(f32x4*)(oks + d + 4) = ck1[it]; *(f32x4*)(ovs + d) = cv0[it]; *(f32x4*)(ovs + d + 4) = cv1[it]; }
                *(LAS u32x4*)(Kl + j * KPITCH + part * 16) = pack8(ck0[it], ck1[it]); const u32x4 vvp = pack8(cv0[it], cv1[it]); VT_SCATTER(part, j, vvp); }
            if (tid < 256) { const int j = 128 + (tid >> 3), part = tid & 7; *(LAS u32x4*)(Kl + j * KPITCH + part * 16) = nk; VT_SCATTER(part, j, nv); }
            __syncthreads();
            if (wave < 2) attn16(Kl, Vt, qf, O + ros, ts, 0, snk, 0, fr, fq);
        }
        __syncthreads();
    }
#undef VT_SCATTER
}

constexpr int WPITCH = 272  , MIX_W = 0, MIX_V = 128 * WPITCH;
__device__ __forceinline__ void mix_phase(PPtr P, int ls, LAS unsigned char* lds, int vcu, int G, int tid, int wave, int lane, bool dummy) {
    bf16_t* U = (bf16_t*)(P->ws + WS_R1); const bf16_t* VR = (const bf16_t*)(P->ws + WS_R1 + (size_t)M * DSGU * 2);
    const float* rstat = (const float*)(P->ws + WS_RSTAT) + (size_t)ls * M * 2; const bf16_t* wtri = (const bf16_t*)(P->ws + WS_WTRI) + (size_t)ls * 4 * 2 * 16384;
    const float* lg = P->in[I_LNG] + ls * DSGU; const float* lb = P->in[I_LNB] + ls * DSGU; float* osg = P->out + O_SG + (size_t)ls * MS * DSGU;
    const float* bsp = P->in[I_BSP] + ls * 4 * 128; const int fr = lane & 15, fq = lane >> 4;
    LAS unsigned char* Wl = lds + MIX_W; LAS unsigned char* Vb = lds + MIX_V;
    constexpr int VBUF = 128 * WPITCH, NUN = 136 * 16;
    const int part = tid & 15, sb = tid >> 4;
#define LDS_BAR() do { asm volatile("s_waitcnt lgkmcnt(0)" ::: "memory"); __builtin_amdgcn_s_barrier(); asm volatile("" ::: "memory"); } while (0)
    u32x4 raw[4]; float st0[4], st1[4]; int wvar = -1;
#define MIX_LOAD(un_) do { const int rc_ = (un_) >> 4, colb_ = (((un_) >> 2) & 3) * 512 + ((un_) & 3) * 128 + part * 8; \
        _Pragma("unroll") for (int k = 0; k < 4; ++k) { const int row_ = rc_ * 128 + sb + 32 * k; raw[k] = *(const u32x4*)(VR + (size_t)row_ * DSGU + colb_); st0[k] = rstat[2 * row_]; st1[k] = rstat[2 * row_ + 1]; } } while (0)
#define MIX_FILL(un_, Vl_) do { const int rc_ = (un_) >> 4, c0 = (((un_) >> 2) & 3) * 512 + ((un_) & 3) * 128 + part * 8; const bool samp_ = rc_ >= 128; \
        const f32x4 g0 = *(const f32x4*)(lg + c0), g1 = *(const f32x4*)(lg + c0 + 4), b0 = *(const f32x4*)(lb + c0), b1 = *(const f32x4*)(lb + c0 + 4); \
        _Pragma("unroll") for (int k = 0; k < 4; ++k) { const int s = sb + 32 * k, row = rc_ * 128 + s; const u32x4 w = raw[k]; \
            const f32x4 x0 = {bf2f(w.x & 0xffffu), bf2f(w.x >> 16), bf2f(w.y & 0xffffu), bf2f(w.y >> 16)}, x1 = {bf2f(w.z & 0xffffu), bf2f(w.z >> 16), bf2f(w.w & 0xffffu), bf2f(w.w >> 16)}; \
            const float mu = st0[k] * (1.0f / DSGU), var_ = fmaxf(st1[k] * (1.0f / DSGU) - mu * mu, 0.f), rs = 1.0f / sqrtf(var_ + EPS); \
            const f32x4 y0 = (x0 - mu) * rs * g0 + b0, y1 = (x1 - mu) * rs * g1 + b1; \
            if (samp_) { float* o = osg + (size_t)(row - MP) * DSGU + c0; *(f32x4*)o = y0; *(f32x4*)(o + 4) = y1; } \
            const u32x4 vv = pack8(y0, y1); const int so = ((((s >> 3) ^ part) << 3) + (s & 7)) * 2; \
            _Pragma("unroll") for (int e = 0; e < 4; ++e) { *(LAS unsigned short*)((Vl_) + (part * 8 + 2 * e) * WPITCH + so) = (unsigned short)(vv[e] & 0xffffu); *(LAS unsigned short*)((Vl_) + (part * 8 + 2 * e + 1) * WPITCH + so) = (unsigned short)(vv[e] >> 16); } } } while (0)
    int un = vcu, cur = 0;
    if (un < NUN) { MIX_LOAD(un); MIX_FILL(un, Vb); if (un + G < NUN) MIX_LOAD(un + G); }
    LDS_BAR();
    for (; un < NUN; un += G, cur ^= 1) {
        const int rc = un >> 4, g = (un >> 2) & 3, cs = un & 3; const bool samp = rc >= 128; const int colb = g * 512 + cs * 128;
        LAS unsigned char* Vl = Vb + cur * VBUF;
        const int var = g * 2 + (samp ? 1 : 0);
        if (var != wvar) { wvar = var; const bf16_t* wt = wtri + (size_t)var * 16384;
#pragma unroll
            for (int k = 0; k < 4; ++k) { const int ci = tid + 512 * k, t = ci >> 4, q = ci & 15; *(LAS u32x4*)(Wl + t * WPITCH + q * 16) = *(const u32x4*)(wt + t * 128 + q * 8); }
            LDS_BAR(); }
        u32x2 uws[8]; float bss[8];
#pragma unroll
        for (int tt = 0; tt < 8; ++tt) { const int t = tt * 16 + fr; uws[tt] = *(const u32x2*)(U + (size_t)(rc * 128 + t) * DSGU + colb + wave * 16 + 4 * fq); bss[tt] = bsp[g * 128 + (samp ? (t & 7) : t)]; }
        if (un + G < NUN) { MIX_FILL(un + G, Vb + (cur ^ 1) * VBUF); if (un + 2 * G < NUN) MIX_LOAD(un + 2 * G); }
        bf16x8 vf[4];
#pragma unroll
        for (int ks = 0; ks < 4; ++ks) vf[ks] = *(const LAS bf16x8*)(Vl + (wave * 16 + fr) * WPITCH + (((4 * ks + fq) ^ (wave * 2 + (fr >> 3))) << 4));
#pragma unroll
        for (int tt = 0; tt < 8; ++tt) { f32x4 acc = {0.f, 0.f, 0.f, 0.f};
#pragma unroll
            for (int ks = 0; ks < 4; ++ks) if (ks <= tt / 2) { const bf16x8 wf = *(const LAS bf16x8*)(Wl + (tt * 16 + fr) * WPITCH + (32 * ks + 8 * fq) * 2); acc = __builtin_amdgcn_mfma_f32_16x16x32_bf16(vf[ks], wf, acc, 0, 0, 0); }
            const int t = tt * 16 + fr; const float bias = bss[tt];
            bf16_t* up = U + (size_t)(rc * 128 + t) * DSGU + colb + wave * 16 + 4 * fq; const u32x2 uw = uws[tt];
            u32x2 w; w.x = cvt_pk_bf16(bf2f(uw.x & 0xffffu) * (acc[0] + bias), bf2f(uw.x >> 16) * (acc[1] + bias)); w.y = cvt_pk_bf16(bf2f(uw.y & 0xffffu) * (acc[2] + bias), bf2f(uw.y >> 16) * (acc[3] + bias));
            *(u32x2*)(dummy ? up + (size_t)68 * MiB : up) = w; }
        LDS_BAR();
    }
#undef MIX_LOAD
#undef MIX_FILL
#undef LDS_BAR
}

#define XB_TMO      128
#define XB_XCNT(j)  (256  + 64 * (j))
#define XB_XSUB(j)  (1280 + 64 * (j))
#define XB_XGEN(j)  (2304 + 64 * (j))
#define XB_TOP      3328
#define XB_TOPGEN   3392
#define XCD_BAR_WORDS 3456
#define XB_SPIN_CAP (1u << 18)

__device__ __forceinline__ unsigned xb_ld(unsigned* p)              { return __hip_atomic_load(p, __ATOMIC_RELAXED, __HIP_MEMORY_SCOPE_AGENT); }
__device__ __forceinline__ unsigned xb_add(unsigned* p, unsigned v) { return __hip_atomic_fetch_add(p, v, __ATOMIC_RELAXED, __HIP_MEMORY_SCOPE_AGENT); }
__device__ __forceinline__ unsigned xb_xcc_id() { return (unsigned)__builtin_amdgcn_s_getreg((3 << 11) | 20) & 0xFu; }
#define XB_SPIN(cond, bar) do { unsigned _sp = 0; while (cond) { __builtin_amdgcn_s_sleep(1); \
    if ((++_sp & 255u) == 0u) { if (xb_ld(&(bar)[XB_TMO])) break; if (_sp > XB_SPIN_CAP) { atomicAdd(&(bar)[XB_TMO], 1u); break; } } } } while (0)

struct XcdBarrier {
    unsigned* bar; unsigned x;
    volatile LAS unsigned* st;
};

__device__ __forceinline__ XcdBarrier xcd_barrier_post(unsigned* bar, volatile LAS unsigned* st) {
    XcdBarrier b; b.bar = bar; b.x = xb_xcc_id(); b.st = st;
    if (threadIdx.x == 0) (void)xb_add(&bar[XB_XCNT(b.x)], 1u);
    return b;
}
__device__ __forceinline__ void xcd_barrier_complete(unsigned* bar, unsigned x, unsigned& nloc, unsigned& nx) {
    const unsigned G = gridDim.x * gridDim.y * gridDim.z;
    unsigned sum, cnt, mine, sp = 0u;
    for (;;) {
        sum = 0u; cnt = 0u; mine = 0u;
#pragma unroll
        for (unsigned j = 0; j < 16; ++j) { const unsigned c = xb_ld(&bar[XB_XCNT(j)]); sum += c; cnt += (c > 0u) ? 1u : 0u; mine = (j == x) ? c : mine; }
        if (sum == G) break;
        __builtin_amdgcn_s_sleep(1);
        if ((++sp & 255u) == 0u) { if (xb_ld(&bar[XB_TMO])) break; if (sp > XB_SPIN_CAP) { atomicAdd(&bar[XB_TMO], 1u); break; } }
    }
    nloc = mine > 0u ? mine : 1u; nx = cnt > 0u ? cnt : 1u;
}

__device__ __forceinline__ void xcd_barrier(const XcdBarrier& b) {
    asm volatile("s_waitcnt vmcnt(0)" ::: "memory");
    __syncthreads();
    if (threadIdx.x == 0) {
        unsigned* bar = b.bar;
        __builtin_amdgcn_s_waitcnt(0);
        unsigned nloc = b.st[0], nx = b.st[1];
        if (nloc == 0u) { xcd_barrier_complete(bar, b.x, nloc, nx); b.st[0] = nloc; b.st[1] = nx; }
        const unsigned old = xb_add(&bar[XB_XSUB(b.x)], 1u);
        const unsigned gen = old / nloc;
        if (old + 1u == (gen + 1u) * nloc) {
            __builtin_amdgcn_fence(__ATOMIC_RELEASE, "agent");
            asm volatile("s_waitcnt vmcnt(0)" ::: "memory");
            const unsigned og = xb_add(&bar[XB_TOP], 1u);
            const unsigned tg = og / nx;
            if (og + 1u == (tg + 1u) * nx) xb_add(&bar[XB_TOPGEN], 1u);
            else XB_SPIN(xb_ld(&bar[XB_TOPGEN]) == tg, bar);
            __builtin_amdgcn_fence(__ATOMIC_ACQUIRE, "agent");
            xb_add(&bar[XB_XGEN(b.x)], 1u);
            asm volatile("s_waitcnt vmcnt(0)" ::: "memory");
        } else {
            XB_SPIN(xb_ld(&bar[XB_XGEN(b.x)]) == gen, bar);
            __builtin_amdgcn_fence(__ATOMIC_ACQUIRE, "agent");
            asm volatile("s_waitcnt vmcnt(0)" ::: "memory");
        }
    }
    __syncthreads();
}

#ifndef DBG_REP_KIND
#define DBG_REP_KIND -1
#endif
#ifndef DBG_REP_N
#define DBG_REP_N 1
#endif
#ifndef DBG_SYNC_N
#define DBG_SYNC_N 1
#endif
#ifndef DBG_MASK
#define DBG_MASK 0xffff
#endif
#define DM_(k) ((DBG_MASK >> (k)) & 1)
constexpr int N_PHASES = 39;
__device__ __forceinline__ bool phase_active(int ph) { if (ph < 2 || ph == 38) return true; const int l = (ph - 2) / 9, k = (ph - 2) % 9; return !(((l & 1) == 0 && k == 3) || ((l & 1) == 1 && k == 2)); }
__global__ void __launch_bounds__(NTHR) fwd_kernel(Params Pval) {
    PPtr P = (PPtr)__builtin_amdgcn_kernarg_segment_ptr();
    extern __shared__ __attribute__((aligned(16))) unsigned char lds_raw[];
    LAS unsigned char* lds = (LAS unsigned char*)lds_raw;
    { int t0 = threadIdx.x; for (int u = t0; u < (LDS_BYTES - 131072) / 4; u += NTHR) ((LAS unsigned*)(lds + 131072))[u] = 0u; }
    __syncthreads();
    const XcdBarrier xbar = xcd_barrier_post((unsigned*)P->ws + 4096, (volatile LAS unsigned*)(lds + 131072 + 320) + 8);
    const int ph_hi = P->ph_hi;
    for (int it = P->ph_lo * DBG_REP_N; it < ph_hi * DBG_REP_N; ++it) {
        const int ph = it / DBG_REP_N;
        if (!phase_active(ph)) continue;
        asm volatile("" : "+s"(P));
        int tid = threadIdx.x; asm volatile("" : "+v"(tid)); const int lane = tid & 63, wave = __builtin_amdgcn_readfirstlane(tid >> 6);
        int G = gridDim.x, bx = blockIdx.x; asm volatile("" : "+s"(G), "+s"(bx)); const int vcu = (G % 8 == 0) ? (bx % 8) * (G / 8) + bx / 8 : bx;
        unsigned char* ws = P->ws; float* mod = (float*)(ws + WS_MOD); const bf16_t* XN = (const bf16_t*)(ws + WS_R2);
        const int gw = vcu * NWAVES + wave, NGW = G * NWAVES;
        int kind, l = 0, li = 0, k = 0;
        if (ph == 0) kind = 0; else if (ph == 1) kind = 1; else if (ph == 38) kind = 2;
        else { l = (ph - 2) / 9; k = (ph - 2) % 9; li = l >> 1; const bool attn = (l & 1) == 0;
            kind = (k == 0 || k == 5) ? 2 : k == 1 ? (attn ? 3 : 6) : k == 2 ? (attn ? 4 : 7) : k == 3 ? 8 : (k == 4 || k == 8) ? 5 : k == 6 ? 9 : 10; }
        if (it % DBG_REP_N != 0 && !(kind == DBG_REP_KIND && ph != 38)) continue;
        if (kind == 0) { if (DM_(0)) prologue_phase(P, lds, gw, NGW, lane, wave); }
        else if (kind == 1) { if (DM_(1)) { pg8::Gemm g{(const bf16_t*)(ws + WS_SC), (const bf16_t*)(ws + WS_R1), 256, MODW, DM}; pg8::StaticOrder S; S.init(256, MODW, G, bx);
            EpiAda E{mod, P->in[I_BADA]}; pg8::gemm_phase<EpiAda, pg8::StaticOrder, true, true>(lds, g, S, E); } }
        else if (kind == 2) { if (DM_(2)) norm_phase(P, l, ph == 38 ? 2 : (k == 5 ? 1 : 0), ph == 2, ph == 2 ? 0 : (ph == 38 || k == 0) ? 11 : 8, gw, NGW, lane); }
        else if (kind == 3) { if (DM_(3)) { pg8::Gemm g{XN, (const bf16_t*)(ws + WS_WQKV) + (size_t)li * QKVN * DM, M, QKVN, DM}; pg8::StaticOrder S; S.init(M, QKVN, G, bx);
            EpiQKV E{(bf16_t*)(ws + WS_R1), (bf16_t*)(ws + WS_R1 + 34 * MiB), (bf16_t*)(ws + WS_R1 + 43 * MiB), P->in[I_BQKV] + li * QKVN, (const float*)(ws + WS_ROPE),
                     P->out + O_KP + (size_t)li * 65536, P->out + O_VP + (size_t)li * 65536, P->out + O_KS + (size_t)li * 4194304, P->out + O_VS + (size_t)li * 4194304};
            pg8::gemm_phase<EpiQKV, pg8::StaticOrder, true, true>(lds, g, S, E); } }
        else if (kind == 4) { if (DM_(4)) attn_phase(P, li, lds, vcu, G, tid, wave, lane); }
        else if (kind == 5) { if (DM_(5)) {
            const bf16_t* A; const bf16_t* Bt; int K; int part = 2;
            if (k == 8) { A = (const bf16_t*)(ws + WS_R2); Bt = (const bf16_t*)(ws + WS_WDN) + (size_t)l * DM * DFF; K = DFF; part = 5; }
            else if ((l & 1) == 0) { A = (const bf16_t*)(ws + WS_R1 + 52 * MiB); Bt = (const bf16_t*)(ws + WS_WO) + (size_t)li * DM * DM; K = DM; }
            else { A = (const bf16_t*)(ws + WS_R1); Bt = (const bf16_t*)(ws + WS_WSO) + (size_t)li * DM * DSGU; K = DSGU; }
            const int ns = K == DFF ? 11 : 8, ntk = K / 64 / ns;
            pg8::Gemm g{A, Bt, M, DM, K}; ResidOrder S; S.init(G, bx, ns, ntk);
            EpiResid E{P->out, (l == 0 && k == 4) ? P->in[I_XP] : (const float*)P->out, mod + l * 6144 + part * DM, (float*)(ws + WS_PART), ntk, (DBG_REP_KIND == 5 && DBG_REP_N > 1 && it % DBG_REP_N == 0) ? 0.f : 1.f}; pg8::gemm_phase<EpiResid, ResidOrder, true, true>(lds, g, S, E); } }
        else if (kind == 6) { if (DM_(6)) { pg8::Gemm g{XN, (const bf16_t*)(ws + WS_WSI) + (size_t)li * 2 * DSGU * DM, M, 2 * DSGU, DM}; pg8::StaticOrder S; S.init(M, 2 * DSGU, G, bx);
            EpiGelu E{(bf16_t*)(ws + WS_R1), (bf16_t*)(ws + WS_R1 + (size_t)M * DSGU * 2), P->in[I_BSI] + li * 2 * DSGU, (float*)(ws + WS_RSTAT) + (size_t)li * M * 2}; pg8::gemm_phase<EpiGelu, pg8::StaticOrder, true, true>(lds, g, S, E); } }
        else if (kind == 8) { if (DM_(8)) mix_phase(P, li, lds, vcu, G, tid, wave, lane, DBG_REP_KIND == 8 && DBG_REP_N > 1 && it % DBG_REP_N == 0); }
        else if (kind == 9) { if (DM_(9)) { pg8::Gemm g{XN, (const bf16_t*)(ws + WS_WUP) + (size_t)l * DFF2 * DM, M, DFF2, DM}; pg8::StaticOrder S; S.init(M, DFF2, G, bx);
            EpiUp E{(bf16_t*)(ws + WS_R1), P->out + O_CP + (size_t)l * 2 * 2 * DFF2, P->out + O_CS + (size_t)l * 128 * 2 * DFF2}; pg8::gemm_phase<EpiUp, pg8::StaticOrder, true, true>(lds, g, S, E); } }
        else { if (DM_(10)) conv_phase(P, l, bx * NTHR + tid, G * NTHR); }
        if (it + 1 < ph_hi * DBG_REP_N) { for (int sr = 0; sr < DBG_SYNC_N; ++sr) { if (ph_hi < 0) { __syncthreads(); cg::this_grid().sync(); } else xcd_barrier(xbar); } }
    }
}

extern "C" void kernel_launch(void* const* d_in, const int* in_sizes, int n_in, void* d_out, int out_size, void* d_ws, size_t ws_size, hipStream_t stream) {
    static int grid = 0;
    if (grid == 0) {
        if (n_in != 27 || (size_t)out_size != O_END || ws_size < WS_END) { fprintf(stderr, "kernel_launch: unexpected shapes: n_in %d out %d ws %zu\n", n_in, out_size, ws_size); grid = -1; return; }
        int dev = 0, cus = 0, per_cu = 0;
        hipGetDevice(&dev); hipDeviceGetAttribute(&cus, hipDeviceAttributeMultiprocessorCount, dev);
        if (hipFuncSetAttribute((const void*)fwd_kernel, hipFuncAttributeMaxDynamicSharedMemorySize, LDS_BYTES) != hipSuccess) { fprintf(stderr, "kernel_launch: hipFuncSetAttribute failed\n"); grid = -1; return; }
        if (hipOccupancyMaxActiveBlocksPerMultiprocessor(&per_cu, (const void*)fwd_kernel, NTHR, LDS_BYTES) != hipSuccess || per_cu < 1) { fprintf(stderr, "kernel_launch: occupancy query says %d\n", per_cu); (void)hipGetLastError(); grid = -1; return; }
        grid = cus;
    }
    if (grid < 0) return;
    Params p; memset(&p, 0, sizeof(p));
    for (int i = 0; i < 27; ++i) p.in[i] = (const float*)d_in[i];
    p.out = (float*)d_out; p.ws = (unsigned char*)d_ws;
    for (int i = 0; i < 8; ++i) p.inv[i] = pow(500000.0, -(double)i / 8.0);
#if MK_PER_PHASE
    for (int ph = 0; ph < N_PHASES; ++ph) { bool act = (ph < 2 || ph == 38) || !((((ph - 2) / 9) & 1) == 0 && (ph - 2) % 9 == 3); if (!act) continue;
        p.ph_lo = ph; p.ph_hi = ph + 1; hipLaunchKernelGGL(fwd_kernel, dim3(grid), dim3(NTHR), LDS_BYTES, stream, p); }
#else
    if (hipMemsetAsync(d_ws, 0, 65536, stream) != hipSuccess) { fprintf(stderr, "kernel_launch: memset failed\n"); return; }
    p.ph_lo = 0; p.ph_hi = N_PHASES; void* args[] = {&p};
    hipError_t e = hipLaunchCooperativeKernel((const void*)fwd_kernel, dim3(grid), dim3(NTHR), args, LDS_BYTES, stream);
    if (e != hipSuccess) fprintf(stderr, "kernel_launch: cooperative launch failed: %s (grid %d)\n", hipGetErrorString(e), grid);
#endif
}
```

```cpp
#include <hip/hip_runtime.h>
#include <hip/hip_cooperative_groups.h>
#include <cstdio>
#include <cstdint>
#include <cstring>
#include <cmath>
namespace cg = cooperative_groups;
namespace pg8 {
#define PG8_LAS __attribute__((address_space(3)))
typedef unsigned short bf16_t;
typedef short bf16x8 __attribute__((ext_vector_type(8)));
typedef float f32x4 __attribute__((ext_vector_type(4)));
typedef unsigned u32x4 __attribute__((ext_vector_type(4)));
constexpr int BM = 256, BK = 64, HALF = 128, HTB = HALF * BK * 2  , STAGE_BYTES = 8 * HTB, NXCD = 8, WGM = 8;

__host__ __device__ __forceinline__ int lds_byte(int r, int c) { const int st = (r >> 4) * 2 + (c >> 5), rr = r & 15, cc = c & 31, ob = rr * 64 + cc * 2; return st * 1024 + (ob ^ (((ob >> 9) & 1) << 5)); }
__host__ __device__ __forceinline__ void stage_rc(int b, int& R, int& C) { const int st = b / 1024, sb = b % 1024, swz = sb ^ (((sb >> 9) & 1) << 5); R = (st >> 1) * 16 + swz / 64; C = (st & 1) * 32 + (swz % 64) / 2; }
__host__ __device__ __forceinline__ int perm32(int rho) { const int n = rho >> 4, i = rho & 15; return 8 * (i >> 2) + 4 * n + (i & 3); }

struct Unit { int pm, pn, k0, nt; };
struct Gemm { const bf16_t* A; const bf16_t* Bt; int M, N, K; };

struct StaticOrder {
    int nM, nN, nwg, G, c;
    __host__ __device__ void init(int M, int N, int G_, int c_) { nM = M / BM; nN = N / BM; nwg = nM * nN; G = G_; c = c_; }
    __host__ __device__ bool next(int i, Unit& u) const {
        const long L = (long)i * G + c; if (L >= nwg) return false;
        int wgid = (int)L; { const int q = nwg / NXCD, r = nwg % NXCD, xcd = wgid % NXCD, off = wgid / NXCD; wgid = (xcd < r ? xcd * (q + 1) : r * (q + 1) + (xcd - r) * q) + off; }
        const int nig = WGM * nN, gid = wgid / nig, fm = gid * WGM, gsz = (nM - fm) < WGM ? (nM - fm) : WGM;
        u.pm = fm + ((wgid % nig) % gsz); u.pn = (wgid % nig) / gsz; u.k0 = 0; u.nt = 0; return true;
    }
    __device__ __forceinline__ void a_ready(const Unit&) const {}
    __device__ __forceinline__ void done(const Unit&) const {}
};

__device__ __forceinline__ unsigned cvt_pk_bf16(float lo, float hi) { unsigned r; asm volatile("v_cvt_pk_bf16_f32 %0, %1, %2" : "=v"(r) : "v"(lo), "v"(hi)); return r; }
typedef float f32x2 __attribute__((ext_vector_type(2)));
template <class Epi, class Sched, bool ALIGN_EPI = false, bool SP2 = false>
__device__ __forceinline__ void gemm_phase(PG8_LAS unsigned char* lds, const Gemm g, const Sched& S, const Epi& E) {
    int tid_ = threadIdx.x; asm volatile("" : "+v"(tid_));
    const int tid = tid_, wid = __builtin_amdgcn_readfirstlane(tid >> 6), lane = tid & 63, wr = wid >> 2, wc = wid & 3, fr = lane & 15, fq = lane >> 4;
    const int K = g.K, nt = K / BK;
    unsigned voffA[2], voffB[2];
#pragma unroll
    for (int i = 0; i < 2; ++i) { int R, C; stage_rc(tid * 16 + i * 8192, R, C); const int Rb = Epi::PERM ? ((R & ~31) + perm32(R & 31)) : R;
        voffA[i] = (unsigned)(R * K + C) * 2u; voffB[i] = (unsigned)(Rb * K + C) * 2u; }
    const size_t kstep = (size_t)(BK * 2);
    const size_t hstep = (size_t)HALF * K * 2;
    const size_t tstep = 2 * hstep;
    const unsigned ldsw = (unsigned)wid * 1024u;
    const int aoff = lds_byte(wr * 64 + fr, fq * 8), boff = lds_byte(wc * 32 + fr, fq * 8);
#define PG8_SA(b, h) (((b) * 2 + (h)) * HTB)
#define PG8_SB(b, h) ((4 + (b) * 2 + (h)) * HTB)
#define PG8_STAGE(bufoff, gbase, voff) do { _Pragma("unroll") for (int _i = 0; _i < 2; ++_i) \
        __builtin_amdgcn_global_load_lds((const unsigned*)((const char*)(gbase) + (voff)[_i]), (PG8_LAS unsigned*)(lds + (bufoff) + ldsw + _i * 8192), 16, 0, 0); } while (0)
#define PG8_LDA(dst, b, h) do { _Pragma("unroll") for (int m = 0; m < 4; ++m) _Pragma("unroll") for (int k = 0; k < 2; ++k) dst[m][k] = *(const PG8_LAS bf16x8*)(lds + PG8_SA(b, h) + aoff + m * 2048 + k * 1024); } while (0)
#define PG8_LDB(dst, b, h) do { _Pragma("unroll") for (int n = 0; n < 2; ++n) _Pragma("unroll") for (int k = 0; k < 2; ++k) dst[n][k] = *(const PG8_LAS bf16x8*)(lds + PG8_SB(b, h) + boff + n * 2048 + k * 1024); } while (0)
#define PG8_MMA(ai, bj, At, Bt) do { __builtin_amdgcn_s_setprio(1); _Pragma("unroll") for (int m = 0; m < 4; ++m) _Pragma("unroll") for (int n = 0; n < 2; ++n) _Pragma("unroll") for (int k = 0; k < 2; ++k) \
        acc[ai][bj][m][n] = __builtin_amdgcn_mfma_f32_16x16x32_bf16(Bt[n][k], At[m][k], acc[ai][bj][m][n], 0, 0, 0); __builtin_amdgcn_s_setprio(0); } while (0)
#define PG8_WAIT_V(n) asm volatile("s_waitcnt vmcnt(" #n ")" ::: "memory")
#define PG8_WAIT_L(n) asm volatile("s_waitcnt lgkmcnt(" #n ")" ::: "memory")
#define PG8_BAR __builtin_amdgcn_s_barrier()
#define PG8_SCHED __builtin_amdgcn_sched_barrier(0)
    Unit cur, nxt; int ui = 0;
    if (!S.next(0, cur)) return;
    f32x4 acc[2][2][4][2];
#pragma unroll
    for (int a = 0; a < 2; ++a)
#pragma unroll
        for (int b = 0; b < 2; ++b)
#pragma unroll
            for (int m = 0; m < 4; ++m)
#pragma unroll
                for (int n = 0; n < 2; ++n) acc[a][b][m][n] = (f32x4){0.f, 0.f, 0.f, 0.f};
    if constexpr (Epi::HAS_INIT) E.init(acc, cur, wr, wc, fr, fq);
    bf16x8 At[4][2], B0[2][2], B1[2][2];
    const char* cA = (const char*)g.A + (size_t)cur.pm * tstep + (size_t)cur.k0 * kstep; const char* cB = (const char*)g.Bt + (size_t)cur.pn * tstep + (size_t)cur.k0 * kstep;
    S.a_ready(cur);
    if constexpr (SP2) {
        PG8_STAGE(PG8_SB(0, 0), cB, voffB); PG8_STAGE(PG8_SB(0, 1), cB + hstep, voffB); PG8_STAGE(PG8_SA(0, 0), cA, voffA); PG8_STAGE(PG8_SA(0, 1), cA + hstep, voffA);
        if (wr == 1) PG8_BAR;
        PG8_WAIT_V(2); PG8_BAR;
        PG8_STAGE(PG8_SB(1, 0), cB + kstep, voffB); PG8_STAGE(PG8_SA(1, 0), cA + kstep, voffA); PG8_STAGE(PG8_SB(1, 1), cB + hstep + kstep, voffB);
        PG8_WAIT_V(6); PG8_BAR;
    } else {
        PG8_STAGE(PG8_SB(0, 0), cB, voffB); PG8_STAGE(PG8_SA(0, 0), cA, voffA); PG8_STAGE(PG8_SB(0, 1), cB + hstep, voffB); PG8_STAGE(PG8_SA(0, 1), cA + hstep, voffA);
        if (wr == 1) PG8_BAR;
        PG8_WAIT_V(4); PG8_BAR;
        PG8_STAGE(PG8_SB(1, 0), cB + kstep, voffB); PG8_STAGE(PG8_SA(1, 0), cA + kstep, voffA); PG8_STAGE(PG8_SB(1, 1), cB + hstep + kstep, voffB);
        PG8_WAIT_V(6); PG8_BAR;
    }
    for (;;) {
        const bool has_next = S.next(ui + 1, nxt);
        const char* nA = has_next ? (const char*)g.A + (size_t)nxt.pm * tstep + (size_t)nxt.k0 * kstep : cA; const char* nB = has_next ? (const char*)g.Bt + (size_t)nxt.pn * tstep + (size_t)nxt.k0 * kstep : cB;
        const int cnt = cur.nt ? cur.nt : nt;
        for (int t = 0; t < cnt; t += 2) {
            const bool last = (t == cnt - 2);
            const char* a1 = cA + (size_t)(t + 1) * kstep;
            const char* a2 = last ? nA : cA + (size_t)(t + 2) * kstep; const char* b2 = last ? nB : cB + (size_t)(t + 2) * kstep;
            const char* a3 = a2 + kstep; const char* b3 = b2 + kstep;
            if (last && has_next) S.a_ready(nxt);
            if constexpr (SP2) {
            PG8_LDB(B0, 0, 0); PG8_LDB(B1, 0, 1); PG8_SCHED; PG8_LDA(At, 0, 0); PG8_STAGE(PG8_SA(1, 1), a1 + hstep, voffA);
            PG8_WAIT_V(8); PG8_WAIT_L(0); PG8_BAR; PG8_MMA(0, 0, At, B0); PG8_MMA(0, 1, At, B1); PG8_BAR; PG8_SCHED;
            PG8_LDA(At, 0, 1); PG8_STAGE(PG8_SB(0, 0), b2, voffB); PG8_STAGE(PG8_SB(0, 1), b2 + hstep, voffB); PG8_STAGE(PG8_SA(0, 0), a2, voffA);
            PG8_WAIT_V(8); PG8_WAIT_L(0); PG8_BAR; PG8_MMA(1, 0, At, B0); PG8_MMA(1, 1, At, B1); PG8_BAR; PG8_SCHED;
            PG8_LDB(B0, 1, 0); PG8_LDB(B1, 1, 1); PG8_SCHED; PG8_LDA(At, 1, 0); PG8_STAGE(PG8_SA(0, 1), a2 + hstep, voffA);
            PG8_WAIT_V(8); PG8_WAIT_L(0); PG8_BAR; PG8_MMA(0, 0, At, B0); PG8_MMA(0, 1, At, B1); PG8_BAR; PG8_SCHED;
            PG8_LDA(At, 1, 1); PG8_STAGE(PG8_SB(1, 0), b3, voffB); PG8_STAGE(PG8_SB(1, 1), b3 + hstep, voffB); PG8_STAGE(PG8_SA(1, 0), a3, voffA);
            PG8_WAIT_V(8); PG8_WAIT_L(0); PG8_BAR; PG8_MMA(1, 0, At, B0); PG8_MMA(1, 1, At, B1); PG8_BAR; PG8_SCHED;
            } else {
            PG8_LDB(B0, 0, 0); PG8_SCHED; PG8_LDA(At, 0, 0); PG8_STAGE(PG8_SA(1, 1), a1 + hstep, voffA);
            PG8_WAIT_L(8); PG8_BAR; PG8_WAIT_L(0); PG8_MMA(0, 0, At, B0); PG8_BAR; PG8_SCHED;
            PG8_LDB(B1, 0, 1); PG8_STAGE(PG8_SB(0, 0), b2, voffB);
            PG8_BAR; PG8_WAIT_L(0); PG8_MMA(0, 1, At, B1); PG8_BAR;
            PG8_LDA(At, 0, 1); PG8_STAGE(PG8_SA(0, 0), a2, voffA);
            PG8_BAR; PG8_WAIT_L(0); PG8_MMA(1, 0, At, B0); PG8_BAR; PG8_SCHED;
            PG8_STAGE(PG8_SB(0, 1), b2 + hstep, voffB);
            PG8_WAIT_V(6); PG8_BAR; PG8_MMA(1, 1, At, B1); PG8_BAR;
            PG8_LDB(B0, 1, 0); PG8_SCHED; PG8_LDA(At, 1, 0); PG8_STAGE(PG8_SA(0, 1), a2 + hstep, voffA);
            PG8_WAIT_L(8); PG8_BAR; PG8_WAIT_L(0); PG8_MMA(0, 0, At, B0); PG8_BAR; PG8_SCHED;
            PG8_LDB(B1, 1, 1); PG8_STAGE(PG8_SB(1, 0), b3, voffB);
            PG8_BAR; PG8_WAIT_L(0); PG8_MMA(0, 1, At, B1); PG8_BAR;
            PG8_LDA(At, 1, 1); PG8_STAGE(PG8_SA(1, 0), a3, voffA);
            PG8_BAR; PG8_WAIT_L(0); PG8_MMA(1, 0, At, B0); PG8_BAR; PG8_SCHED;
            PG8_STAGE(PG8_SB(1, 1), b3 + hstep, voffB);
            PG8_WAIT_V(6); PG8_BAR; PG8_MMA(1, 1, At, B1); PG8_BAR;
            }
        }
        if constexpr (ALIGN_EPI) { if (wr == 0) PG8_BAR; }
        if constexpr (!Epi::AFTER_DRAIN) { E(acc, cur, wr, wc, fr, fq); S.done(cur); }
        if (!has_next) break;
#pragma unroll
        for (int a = 0; a < 2; ++a)
#pragma unroll
            for (int b = 0; b < 2; ++b)
#pragma unroll
                for (int m = 0; m < 4; ++m)
#pragma unroll
                    for (int n = 0; n < 2; ++n) acc[a][b][m][n] = (f32x4){0.f, 0.f, 0.f, 0.f};
        cur = nxt; cA = nA; cB = nB; ++ui;
        if constexpr (Epi::HAS_INIT) E.init(acc, cur, wr, wc, fr, fq);
        if constexpr (ALIGN_EPI) { if (wr == 1) PG8_BAR; }
    }
    PG8_WAIT_V(0);
    if constexpr (!ALIGN_EPI) { if (wr == 0) PG8_BAR; }
    PG8_BAR;
    if constexpr (Epi::AFTER_DRAIN) { E.fused(acc, cur, wr, wc, fr, fq, lds, wid, lane); S.done(cur); }
#undef PG8_SA
#undef PG8_SB
#undef PG8_STAGE
#undef PG8_LDA
#undef PG8_LDB
#undef PG8_MMA
#undef PG8_WAIT_V
#undef PG8_WAIT_L
#undef PG8_BAR
#undef PG8_SCHED
}
}

#ifndef MK_PER_PHASE
#define MK_PER_PHASE 0
#endif
using pg8::bf16_t; using pg8::bf16x8; using pg8::f32x4; using pg8::u32x4; using pg8::cvt_pk_bf16; using pg8::Unit;
#ifndef LAS
#define LAS __attribute__((address_space(3)))
#endif
typedef unsigned u32x2 __attribute__((ext_vector_type(2)));
constexpr int DM = 1024, MP = 16384, MS = 1024, M = MP + MS, SEQ = 8192, NSEQ = 130, DEPTH = 4;
constexpr int DFF = 2816, DFF2 = 5632, DSGU = 2048, QKVN = 1536, MODW = 6144 * DEPTH, NPOS = 8200;
constexpr float EPS = 1e-6f, LOG2E = 1.4426950408889634f, QSCALE = 0.125f * LOG2E;
constexpr int NWAVES = 8, NTHR = 512;
constexpr size_t O_Y = 0, O_KP = (size_t)M * DM, O_VP = O_KP + 131072, O_CP = O_VP + 131072, O_KS = O_CP + 90112,
                 O_VS = O_KS + 8388608, O_CS = O_VS + 8388608, O_SG = O_CS + 5767168, O_END = O_SG + 4194304;
constexpr size_t MiB = 1u << 20;
constexpr size_t WS_RSTAT = 128 * 1024  , WS_WTRI = 2 * MiB + 512 * 1024  ;
constexpr size_t WS_ROPE = 1 * MiB, WS_SC = 2 * MiB, WS_MOD = 3 * MiB, WS_WQKV = 16 * MiB, WS_WO = 22 * MiB, WS_WSI = 26 * MiB, WS_WSO = 42 * MiB,
                 WS_WUP = 50 * MiB, WS_WDN = 94 * MiB, WS_R2 = 116 * MiB, WS_R1 = 210 * MiB, WS_END = 397 * MiB;
constexpr size_t WS_PART = WS_R1 + 140 * MiB;
static_assert(WS_PART + 11 * (size_t)MS * DM * 4 <= WS_END, "partials");
static_assert(WS_R2 + (size_t)M * DFF * 2 <= WS_R1 && WS_R1 + (size_t)M * DFF2 * 2 <= WS_END && WS_MOD + (size_t)NSEQ * MODW * 4 <= WS_WQKV, "ws map");
constexpr int LDS_BYTES = 147456;

struct Params { const float* in[27]; float* out; unsigned char* ws; double inv[8]; int ph_lo, ph_hi; };
#define CAS __attribute__((address_space(4)))
typedef const CAS Params* PPtr;
enum { I_XP = 0, I_XS, I_CP, I_CS, I_CK, I_CV, I_SCONV, I_WADA, I_BADA, I_NMIX, I_NFFN, I_WQKV, I_BQKV, I_SINK, I_WO, I_WSI, I_BSI, I_LNG, I_LNB,
       I_WSP, I_BSP, I_WSO, I_WUP, I_CW, I_CB, I_WDN, I_NFIN };

__device__ __forceinline__ void row_info(int r, int& seq, int& t) { if (r < MP) { seq = r >> 13; t = r & 8191; } else { const int q = r - MP; seq = 2 + (q >> 3); t = q & 7; } }
__device__ __forceinline__ float wave_sum(float v) {
#pragma unroll
    for (int o = 1; o < 64; o <<= 1) v += __shfl_xor(v, o);
    return v;
}
__device__ __forceinline__ float bf2f(unsigned h) { return __uint_as_float(h << 16); }
__device__ __forceinline__ u32x4 pack8(const f32x4 a, const f32x4 b) { u32x4 w; w.x = cvt_pk_bf16(a[0], a[1]); w.y = cvt_pk_bf16(a[2], a[3]); w.z = cvt_pk_bf16(b[0], b[1]); w.w = cvt_pk_bf16(b[2], b[3]); return w; }

#ifndef NT_STORES
#define NT_STORES 0
#endif
__device__ __forceinline__ void st16(void* p, u32x4 v) { if (NT_STORES) __builtin_nontemporal_store(v, (u32x4*)p); else *(u32x4*)p = v; }
__device__ __forceinline__ void st8(void* p, u32x2 v) { if (NT_STORES) __builtin_nontemporal_store(v, (u32x2*)p); else *(u32x2*)p = v; }
struct EpiAda { static constexpr bool PERM = true, AFTER_DRAIN = false, HAS_INIT = false; float* mod; const float* bias;
    __device__ __forceinline__ void operator()(const f32x4 (&acc)[2][2][4][2], const Unit& u, int wr, int wc, int fr, int fq) const {
        const int row0 = u.pm * 256 + wr * 64 + fr, col0 = u.pn * 256 + wc * 32 + 8 * fq;
        f32x4 bv[2][2];
#pragma unroll
        for (int bj = 0; bj < 2; ++bj)
#pragma unroll
            for (int n = 0; n < 2; ++n) bv[bj][n] = *(const f32x4*)(bias + col0 + bj * 128 + 4 * n);
#pragma unroll
        for (int ai = 0; ai < 2; ++ai)
#pragma unroll
            for (int m = 0; m < 4; ++m) { const int r = row0 + ai * 128 + m * 16; if (r < NSEQ) {
#pragma unroll
                for (int bj = 0; bj < 2; ++bj) { float* d = mod + (size_t)r * MODW + col0 + bj * 128;
                    *(f32x4*)d = acc[ai][bj][m][0] + bv[bj][0]; *(f32x4*)(d + 4) = acc[ai][bj][m][1] + bv[bj][1]; } } }
    }
};
__device__ __forceinline__ f32x4 gate_safe(f32x4 g) { f32x4 r;
#pragma unroll
    for (int e = 0; e < 4; ++e) r[e] = __builtin_copysignf(fmaxf(fabsf(g[e]), 1e-30f), g[e]);
    return r; }
struct EpiResid { static constexpr bool PERM = false, AFTER_DRAIN = false, HAS_INIT = false;     float* x; const float* xin; const float* gate; float* part; int ntk; float gscale;
    __device__ __forceinline__ void init(f32x4 (&acc)[2][2][4][2], const Unit& u, int wr, int wc, int fr, int fq) const {
        if (u.nt) return;
        const int row0 = u.pm * 256 + wr * 64 + fr, col0 = u.pn * 256 + wc * 32 + 4 * fq;
#pragma unroll
        for (int ai = 0; ai < 2; ++ai)
#pragma unroll
            for (int m = 0; m < 4; ++m) { const int r = row0 + ai * 128 + m * 16; int seq, t; row_info(r, seq, t);
                const float* xr = x + (size_t)r * DM + col0; const float* gr = gate + (size_t)seq * MODW + col0;
#pragma unroll
                for (int bj = 0; bj < 2; ++bj)
#pragma unroll
                    for (int n = 0; n < 2; ++n) { const int o = bj * 128 + 16 * n; const f32x4 xv = *(const f32x4*)(xr + o), gv = gate_safe(*(const f32x4*)(gr + o));
#pragma unroll
                        for (int e = 0; e < 4; ++e) acc[ai][bj][m][n][e] = xv[e] * __builtin_amdgcn_rcpf(gv[e]); } }
    }
    __device__ __forceinline__ void operator()(const f32x4 (&acc)[2][2][4][2], const Unit& u, int wr, int wc, int fr, int fq) const {
        const int row0 = u.pm * 256 + wr * 64 + fr, col0 = u.pn * 256 + wc * 32 + 4 * fq;
        if (u.nt) {
#pragma unroll
            for (int ai = 0; ai < 2; ++ai) { f32x4 gq[4][2][2];
#pragma unroll
                for (int m = 0; m < 4; ++m) { const int r = row0 + ai * 128 + m * 16; int seq, t; row_info(r, seq, t); const float* gr = gate + (size_t)seq * MODW + col0;
#pragma unroll
                    for (int bj = 0; bj < 2; ++bj)
#pragma unroll
                        for (int n = 0; n < 2; ++n) gq[m][bj][n] = *(const f32x4*)(gr + bj * 128 + 16 * n); }
#pragma unroll
                for (int m = 0; m < 4; ++m) { const int r = row0 + ai * 128 + m * 16; float* pr = part + ((size_t)(u.k0 / ntk) * MS + (r - MP)) * DM + col0;
#pragma unroll
                    for (int bj = 0; bj < 2; ++bj)
#pragma unroll
                        for (int n = 0; n < 2; ++n) *(f32x4*)(pr + bj * 128 + 16 * n) = gq[m][bj][n] * gscale * acc[ai][bj][m][n]; }
                asm volatile("" ::: "memory"); }
        } else {
            int seq0, t0; row_info(u.pm * 256, seq0, t0); const float* gr = gate + (size_t)seq0 * MODW + col0;
            f32x4 gv[2][2];
#pragma unroll
            for (int bj = 0; bj < 2; ++bj)
#pragma unroll
                for (int n = 0; n < 2; ++n) gv[bj][n] = *(const f32x4*)(gr + bj * 128 + 16 * n) * gscale;
#pragma unroll
            for (int ai = 0; ai < 2; ++ai) { f32x4 xv[4][2][2];
#pragma unroll
                for (int m = 0; m < 4; ++m)
#pragma unroll
                    for (int bj = 0; bj < 2; ++bj)
#pragma unroll
                        for (int n = 0; n < 2; ++n) xv[m][bj][n] = *(const f32x4*)(xin + (size_t)(row0 + ai * 128 + m * 16) * DM + col0 + bj * 128 + 16 * n);
#pragma unroll
                for (int m = 0; m < 4; ++m)
#pragma unroll
                    for (int bj = 0; bj < 2; ++bj)
#pragma unroll
                        for (int n = 0; n < 2; ++n) *(f32x4*)(x + (size_t)(row0 + ai * 128 + m * 16) * DM + col0 + bj * 128 + 16 * n) = xv[m][bj][n] + gv[bj][n] * acc[ai][bj][m][n];
                asm volatile("" ::: "memory"); }
        }
    }
};
__device__ __forceinline__ float gelu_tanh(float x) { const float y = x * (1.0f + 0.044715f * x * x) * (1.5957691216057308f * LOG2E); return x * __builtin_amdgcn_rcpf(1.0f + __builtin_amdgcn_exp2f(-y)); }
struct EpiGelu { static constexpr bool PERM = true, AFTER_DRAIN = false, HAS_INIT = false; bf16_t* U; bf16_t* V; const float* bias; float* rstat;
    __device__ __forceinline__ void operator()(const f32x4 (&acc)[2][2][4][2], const Unit& u, int wr, int wc, int fr, int fq) const {
        const int row0 = u.pm * 256 + wr * 64 + fr, colt = u.pn * 256, col0 = colt + wc * 32 + 8 * fq;
        bf16_t* base = (colt < DSGU ? U : V) + ((col0) & (DSGU - 1));
        f32x4 bv[2][2];
#pragma unroll
        for (int bj = 0; bj < 2; ++bj)
#pragma unroll
            for (int n = 0; n < 2; ++n) bv[bj][n] = *(const f32x4*)(bias + col0 + bj * 128 + 4 * n);
#pragma unroll
        for (int ai = 0; ai < 2; ++ai)
#pragma unroll
            for (int m = 0; m < 4; ++m) { const int r = row0 + ai * 128 + m * 16; float s1 = 0.f, s2 = 0.f;
#pragma unroll
                for (int bj = 0; bj < 2; ++bj) { f32x4 v0 = acc[ai][bj][m][0] + bv[bj][0], v1 = acc[ai][bj][m][1] + bv[bj][1];
#pragma unroll
                    for (int e = 0; e < 4; ++e) { v0[e] = gelu_tanh(v0[e]); v1[e] = gelu_tanh(v1[e]); s1 += v0[e] + v1[e]; s2 += v0[e] * v0[e] + v1[e] * v1[e]; }
                    st16(base + (size_t)r * DSGU + bj * 128, pack8(v0, v1)); }
                if (colt >= DSGU) { s1 += __shfl_xor(s1, 16); s2 += __shfl_xor(s2, 16); s1 += __shfl_xor(s1, 32); s2 += __shfl_xor(s2, 32);
                    if (fq == 0) { unsafeAtomicAdd(rstat + 2 * r, s1); unsafeAtomicAdd(rstat + 2 * r + 1, s2); } } }
    }
};
struct EpiUp { static constexpr bool PERM = true, AFTER_DRAIN = false, HAS_INIT = false; bf16_t* a; float* ocp; float* ocs;
    __device__ __forceinline__ void operator()(const f32x4 (&acc)[2][2][4][2], const Unit& u, int wr, int wc, int fr, int fq) const {
        const int row0 = u.pm * 256 + wr * 64 + fr, col0 = u.pn * 256 + wc * 32 + 8 * fq;
#pragma unroll
        for (int ai = 0; ai < 2; ++ai)
#pragma unroll
            for (int m = 0; m < 4; ++m) { const int r = row0 + ai * 128 + m * 16; int seq, t; row_info(r, seq, t);
                float* tail = nullptr;
                if (r < MP) { if (t >= SEQ - 2) tail = ocp + (size_t)(seq * 2 + (t - (SEQ - 2))) * DFF2; }
                else if (t >= 6) tail = ocs + (size_t)((seq - 2) * 2 + (t - 6)) * DFF2;
#pragma unroll
                for (int bj = 0; bj < 2; ++bj) { const int c = col0 + bj * 128;
                    st16(a + (size_t)r * DFF2 + c, pack8(acc[ai][bj][m][0], acc[ai][bj][m][1]));
                    if (tail) { *(f32x4*)(tail + c) = acc[ai][bj][m][0]; *(f32x4*)(tail + c + 4) = acc[ai][bj][m][1]; } } }
    }
};
struct EpiQKV { static constexpr bool PERM = true, AFTER_DRAIN = false, HAS_INIT = false; bf16_t *Q, *K, *V; const float* bias; const float* rope; float *okp, *ovp, *oks, *ovs;
    __device__ __forceinline__ void operator()(const f32x4 (&acc)[2][2][4][2], const Unit& u, int wr, int wc, int fr, int fq) const {
        const int row0 = u.pm * 256 + wr * 64 + fr, colt = u.pn * 256, col0 = colt + wc * 32 + 8 * fq;
        const int kind = colt < 1024 ? 0 : (colt < 1280 ? 1 : 2);
        const bool do_rope = kind < 2 && (wc & 1) == 0;
        const float sgn = fq == 0 ? -1.f : 1.f;
        f32x4 bv[2][2];
#pragma unroll
        for (int bj = 0; bj < 2; ++bj)
#pragma unroll
            for (int n = 0; n < 2; ++n) bv[bj][n] = *(const f32x4*)(bias + col0 + bj * 128 + 4 * n);
        f32x4 rc0[2], rc1[2], rs0[2], rs1[2];
#pragma unroll
        for (int mm = 0; mm < 2; ++mm) { rc0[mm] = rc1[mm] = (f32x4){1.f, 1.f, 1.f, 1.f}; rs0[mm] = rs1[mm] = (f32x4){0.f, 0.f, 0.f, 0.f}; }
#pragma unroll
        for (int ai = 0; ai < 2; ++ai)
#pragma unroll
            for (int m = 0; m < 4; ++m) { const int r = row0 + ai * 128 + m * 16; int seq, t; row_info(r, seq, t);
                if ((m & 1) == 0 && do_rope && fq < 2) {
#pragma unroll
                    for (int mm = m; mm < m + 2; ++mm) { const int r_ = row0 + ai * 128 + mm * 16; int sq_, t_; row_info(r_, sq_, t_); const float* rp = rope + (size_t)(r_ < MP ? t_ : SEQ + t_) * 16;
                        rc0[mm & 1] = *(const f32x4*)rp; rc1[mm & 1] = *(const f32x4*)(rp + 4); rs0[mm & 1] = *(const f32x4*)(rp + 8) * sgn; rs1[mm & 1] = *(const f32x4*)(rp + 12) * sgn; } }
                const f32x4 c0 = rc0[m & 1], c1 = rc1[m & 1], s0 = rs0[m & 1], s1 = rs1[m & 1];
                float* tk = nullptr;
                if (kind > 0) { float* ob_p = kind == 1 ? okp : ovp; float* ob_s = kind == 1 ? oks : ovs;
                    if (r < MP) { if (t >= SEQ - 128) tk = ob_p + (size_t)(seq * 128 + (t - (SEQ - 128))) * 256; }
                    else tk = ob_s + (size_t)((seq - 2) * 128 + 120 + t) * 256; }
#pragma unroll
                for (int bj = 0; bj < 2; ++bj) { f32x4 v0 = acc[ai][bj][m][0] + bv[bj][0], v1 = acc[ai][bj][m][1] + bv[bj][1];
                    if (do_rope) { f32x4 p0, p1;
#pragma unroll
                        for (int e = 0; e < 4; ++e) { p0[e] = __shfl_xor(v0[e], 16); p1[e] = __shfl_xor(v1[e], 16); }
                        v0 = v0 * c0 + p0 * s0; v1 = v1 * c1 + p1 * s1; }
                    const int cl = (col0 & 255) + bj * 128;
                    if (kind == 0) { v0 = v0 * QSCALE; v1 = v1 * QSCALE; st16(Q + (size_t)r * DM + colt + cl, pack8(v0, v1)); }
                    else { bf16_t* dst = (kind == 1 ? K : V) + (size_t)r * 256 + cl; st16(dst, pack8(v0, v1));
                        if (tk) { *(f32x4*)(tk + cl) = v0; *(f32x4*)(tk + cl + 4) = v1; } } } }
    }
};

struct ResidOrder { pg8::StaticOrder so; int S, ntk;
    __device__ void init(int G, int c, int S_, int ntk_) { so.init(MP, DM, G, c); S = S_; ntk = ntk_; }
    __device__ bool next(int i, Unit& u) const {
        if (so.G == so.nwg) {
            const bool has_split = so.c < 16 * S;
            if (has_split && i == 0) { const int t16 = so.c / S, ks = so.c % S; u.pm = MP / 256 + (t16 >> 2); u.pn = t16 & 3; u.k0 = ks * ntk; u.nt = ntk; return true; }
            if (i == (has_split ? 1 : 0)) return so.next(0, u);
            return false; }
        const long L = (long)i * so.G + so.c;
        if (L < so.nwg) return so.next(i, u);
        const int s = (int)(L - so.nwg); if (s >= 16 * S) return false;
        const int t16 = s / S, ks = s % S; u.pm = MP / 256 + (t16 >> 2); u.pn = t16 & 3; u.k0 = ks * ntk; u.nt = ntk; return true;
    }
    __device__ __forceinline__ void a_ready(const Unit&) const {}
    __device__ __forceinline__ void done(const Unit&) const {}
};
__device__ __forceinline__ unsigned f2bf(float f) { unsigned u = __builtin_bit_cast(unsigned, f); return (u + 0x7fffu + ((u >> 16) & 1u)) >> 16; }
__device__ __forceinline__ unsigned pk2(float lo, float hi) { return f2bf(lo) | (f2bf(hi) << 16); }
struct TItem { const float* src; bf16_t* dst; int K, N; };
__device__ __forceinline__ void titem_load(const TItem& t, f32x4 (&v)[8], int lane) {
#pragma unroll
    for (int i = 0; i < 8; ++i) v[i] = *(const f32x4*)(t.src + (size_t)(4 * i + (lane >> 4)) * t.N + (lane & 15) * 4);
}
__device__ __forceinline__ void titem_store(const TItem& t, const f32x4 (&v)[8], LAS float* scr, int lane) {
#pragma unroll
    for (int i = 0; i < 8; ++i) { LAS float* s = scr + (4 * i + (lane >> 4)) * 65 + (lane & 15) * 4; s[0] = v[i][0]; s[1] = v[i][1]; s[2] = v[i][2]; s[3] = v[i][3]; }
    asm volatile("s_waitcnt lgkmcnt(0)" ::: "memory");
#pragma unroll
    for (int j = 0; j < 4; ++j) { const int id = lane + 64 * j, n = id >> 2, c = id & 3; const LAS float* s = scr + (8 * c) * 65 + n;
        u32x4 o; o.x = pk2(s[0 * 65], s[1 * 65]); o.y = pk2(s[2 * 65], s[3 * 65]); o.z = pk2(s[4 * 65], s[5 * 65]); o.w = pk2(s[6 * 65], s[7 * 65]);
        *(u32x4*)(t.dst + (size_t)n * t.K + 8 * c) = o; }
    asm volatile("s_waitcnt lgkmcnt(0)" ::: "memory");
}
__device__ __forceinline__ void prologue_phase(PPtr P, LAS unsigned char* lds, int gw, int NGW, int lane, int wave) {
    LAS float* scr = (LAS float*)(lds + wave * 16384);
    unsigned char* ws = P->ws;
    constexpr int NMAT = 7;
    const int   mi[NMAT] = {I_WADA, I_WQKV, I_WO, I_WSI, I_WSO, I_WUP, I_WDN};
    const int   mk[NMAT] = {DM, DM, DM, DM, DSGU, DM, DFF};
    const int   mn[NMAT] = {6144, QKVN, DM, 2 * DSGU, DM, DFF2, DM};
    const int   ml[NMAT] = {4, 2, 2, 2, 2, 4, 4};
    const size_t mo[NMAT] = {WS_R1, WS_WQKV, WS_WO, WS_WSI, WS_WSO, WS_WUP, WS_WDN};
    int total = 0;
#pragma unroll
    for (int i = 0; i < NMAT; ++i) total += ml[i] * (mk[i] / 32) * (mn[i] / 64);
#define TITEM_DECODE(it_, T_) do { int r_ = (it_); \
        _Pragma("unroll") for (int i = 0; i < NMAT; ++i) { const int per = (mk[i] / 32) * (mn[i] / 64), cnt = ml[i] * per; \
            if (r_ >= 0 && r_ < cnt) { const int l_ = r_ / per, li_ = r_ % per, nblk = mn[i] / 64, kb = li_ / nblk, nb = li_ % nblk; const size_t mat = (size_t)mk[i] * mn[i]; \
                T_.src = P->in[mi[i]] + (size_t)l_ * mat + (size_t)(32 * kb) * mn[i] + 64 * nb; T_.dst = (bf16_t*)(ws + mo[i]) + (size_t)l_ * mat + (size_t)(64 * nb) * mk[i] + 32 * kb; T_.K = mk[i]; T_.N = mn[i]; r_ = -1; } \
            else if (r_ >= 0) r_ -= cnt; } } while (0)
    for (int it = gw; it < total; it += 2 * NGW) {
        TItem ta, tb; f32x4 va[8], vb[8]; const bool two = it + NGW < total;
        TITEM_DECODE(it, ta); titem_load(ta, va, lane);
        if (two) { TITEM_DECODE(it + NGW, tb); titem_load(tb, vb, lane); }
        titem_store(ta, va, scr, lane);
        if (two) titem_store(tb, vb, scr, lane);
    }
#undef TITEM_DECODE
    const int gt = gw * 64 + lane, NGT = NGW * 64;
    float* rope = (float*)(ws + WS_ROPE);
    for (int i = gt; i < NPOS * 8; i += NGT) { const int pos = i >> 3, k = i & 7; const double rev = (double)pos * P->inv[k] * 0.15915494309189535; const float fr = (float)(rev - floor(rev));
        rope[pos * 16 + k] = __builtin_amdgcn_cosf(fr); rope[pos * 16 + 8 + k] = __builtin_amdgcn_sinf(fr); }
    float* rst = (float*)(ws + WS_RSTAT);
    for (int i = gt; i < 2 * M * 2; i += NGT) rst[i] = 0.f;
    bf16_t* wtri = (bf16_t*)(ws + WS_WTRI);
    for (int i = gt; i < 2 * 4 * 2 * 16384; i += NGT) { const int s = i & 127, t = (i >> 7) & 127, var = (i >> 14) & 1, lg = i >> 15; const float* w = P->in[I_WSP] + (size_t)lg * 16384; float v;
        if (var == 0) v = s <= t ? w[t * 128 + s] : 0.f; else v = ((s >> 3) == (t >> 3) && (s & 7) <= (t & 7)) ? w[(t & 7) * 128 + (s & 7)] : 0.f;
        wtri[i] = (bf16_t)f2bf(v); }
    bf16_t* SC = (bf16_t*)(ws + WS_SC);
    for (int i = gt; i < 256 * DM; i += NGT) { const int s = i >> 10, k = i & 1023; float v = 0.f;
        if (s < NSEQ) { const float c = s < 2 ? P->in[I_CP][s * DM + k] : P->in[I_CS][(s - 2) * DM + k]; v = c / (1.0f + __expf(-c)); }
        SC[i] = (bf16_t)f2bf(v); }
}
__device__ __forceinline__ void norm_phase(PPtr P, int l, int mode, bool first, int nsplit, int gw, int NGW, int lane) {
    float* xbuf = P->out; bf16_t* XN = (bf16_t*)(P->ws + WS_R2); const float* mod = (const float*)(P->ws + WS_MOD);
    const float* gw_ = mode == 2 ? P->in[I_NFIN] : (mode == 0 ? P->in[I_NMIX] : P->in[I_NFFN]) + l * DM;
    f32x4 g[4];
#pragma unroll
    for (int j = 0; j < 4; ++j) g[j] = ((const f32x4*)gw_)[lane + 64 * j];
    for (int r = MP + gw; r < M; r += NGW) {
        const float* src = first ? P->in[I_XS] + (size_t)(r - MP) * DM : xbuf + (size_t)r * DM;
        f32x4 v[4], shs[4], scs[4];
#pragma unroll
        for (int j = 0; j < 4; ++j) v[j] = ((const f32x4*)src)[lane + 64 * j];
        if (mode != 2) { int seq, t; row_info(r, seq, t); const float* mr = mod + (size_t)seq * MODW + l * 6144 + (mode ? 3 * DM : 0);
#pragma unroll
            for (int j = 0; j < 4; ++j) { shs[j] = ((const f32x4*)mr)[lane + 64 * j]; scs[j] = ((const f32x4*)(mr + DM))[lane + 64 * j]; } }
        if (nsplit > 0) { const float* pp = (const float*)(P->ws + WS_PART) + (size_t)(r - MP) * DM;
#pragma unroll
            for (int bt = 0; bt < 4; ++bt) { f32x4 pv[3][4];
#pragma unroll
                for (int s = 0; s < 3; ++s) if (bt * 3 + s < nsplit) {
#pragma unroll
                    for (int j = 0; j < 4; ++j) pv[s][j] = ((const f32x4*)(pp + (size_t)(bt * 3 + s) * MS * DM))[lane + 64 * j]; }
#pragma unroll
                for (int s = 0; s < 3; ++s) if (bt * 3 + s < nsplit) {
#pragma unroll
                    for (int j = 0; j < 4; ++j) v[j] += pv[s][j]; }
                asm volatile("" ::: "memory"); } }
        float ss = 0.f;
#pragma unroll
        for (int j = 0; j < 4; ++j) ss += (v[j][0] * v[j][0] + v[j][1] * v[j][1]) + (v[j][2] * v[j][2] + v[j][3] * v[j][3]);
        const float rs = 1.0f / sqrtf(wave_sum(ss) * (1.0f / DM) + EPS);
        if (mode == 2) {
#pragma unroll
            for (int j = 0; j < 4; ++j) ((f32x4*)(xbuf + (size_t)r * DM))[lane + 64 * j] = v[j] * rs * g[j];
        } else {
#pragma unroll
            for (int j = 0; j < 4; ++j) { const f32x4 sh = shs[j], sc = scs[j];
                const f32x4 h = v[j] * rs * g[j] * (sc + 1.0f) + sh; u32x2 w; w.x = cvt_pk_bf16(h[0], h[1]); w.y = cvt_pk_bf16(h[2], h[3]);
                st8((u32x2*)(XN + (size_t)r * DM) + lane + 64 * j, w);
                if (first || nsplit > 0) ((f32x4*)(xbuf + (size_t)r * DM))[lane + 64 * j] = v[j]; } }
    }
    int base = gw, stride = NGW, nk = (MP - gw + NGW - 1) / NGW;
    if (NGW == 2 * MS && MP == 8 * NGW) { stride = MS; if (gw < MS) { base = gw; nk = 6; } else { base = 6 * MS + (gw - MS); nk = 10; } }
    for (int k = 0; k < nk; k += 2) {
        const int r0 = base + stride * k, r1 = r0 + stride; const bool has1 = k + 1 < nk;
        f32x4 v[2][4], sh[2][4], sc[2][4];
#pragma unroll
        for (int q = 0; q < 2; ++q) { const int r = q ? r1 : r0; if (q == 0 || has1) {
            const float* src = first ? P->in[I_XP] + (size_t)r * DM : xbuf + (size_t)r * DM;
#pragma unroll
            for (int j = 0; j < 4; ++j) v[q][j] = ((const f32x4*)src)[lane + 64 * j];
            if (mode != 2) { const float* mr = mod + (size_t)(r >> 13) * MODW + l * 6144 + (mode ? 3 * DM : 0);
#pragma unroll
                for (int j = 0; j < 4; ++j) { sh[q][j] = ((const f32x4*)mr)[lane + 64 * j]; sc[q][j] = ((const f32x4*)(mr + DM))[lane + 64 * j]; } } } }
        float ss[2] = {0.f, 0.f};
#pragma unroll
        for (int q = 0; q < 2; ++q) if (q == 0 || has1) {
#pragma unroll
            for (int j = 0; j < 4; ++j) ss[q] += (v[q][j][0] * v[q][j][0] + v[q][j][1] * v[q][j][1]) + (v[q][j][2] * v[q][j][2] + v[q][j][3] * v[q][j][3]); }
        ss[0] = wave_sum(ss[0]); if (has1) ss[1] = wave_sum(ss[1]);
#pragma unroll
        for (int q = 0; q < 2; ++q) { const int r = q ? r1 : r0; if (q == 0 || has1) {
            const float rs = 1.0f / sqrtf(ss[q] * (1.0f / DM) + EPS);
            if (mode == 2) {
#pragma unroll
                for (int j = 0; j < 4; ++j) ((f32x4*)(xbuf + (size_t)r * DM))[lane + 64 * j] = v[q][j] * rs * g[j];
            } else {
#pragma unroll
                for (int j = 0; j < 4; ++j) { const f32x4 h = v[q][j] * rs * g[j] * (sc[q][j] + 1.0f) + sh[q][j]; u32x2 w; w.x = cvt_pk_bf16(h[0], h[1]); w.y = cvt_pk_bf16(h[2], h[3]);
                    st8((u32x2*)(XN + (size_t)r * DM) + lane + 64 * j, w);
                    }
            } } }
    }
}
__device__ __forceinline__ void ld8bf(const bf16_t* p, f32x4& lo, f32x4& hi) { const u32x4 w = *(const u32x4*)p; lo = (f32x4){bf2f(w.x & 0xffffu), bf2f(w.x >> 16), bf2f(w.y & 0xffffu), bf2f(w.y >> 16)}; hi = (f32x4){bf2f(w.z & 0xffffu), bf2f(w.z >> 16), bf2f(w.w & 0xffffu), bf2f(w.w >> 16)}; }
__device__ __forceinline__ void conv_phase(PPtr P, int l, int gtid, int NGT) {
    const bf16_t* A = (const bf16_t*)(P->ws + WS_R1); bf16_t* HB = (bf16_t*)(P->ws + WS_R2);
    const float* cw = P->in[I_CW] + (size_t)l * 3 * DFF2; const float* cb = P->in[I_CB] + (size_t)l * DFF2; const float* st = P->in[I_SCONV] + (size_t)l * 128 * 2 * DFF2;
    constexpr int NCG = DFF / 8, NITEM = (M / 16) * NCG;
    for (int it = gtid; it < NITEM; it += NGT) {
        const int seg = it / NCG, c = (it % NCG) * 8, r0 = seg * 16; const bool samp = r0 >= MP;
        f32x4 wg[3][2], wu[3][2], bg[2], bu[2];
#pragma unroll
        for (int h = 0; h < 2; ++h) {
#pragma unroll
            for (int j = 0; j < 3; ++j) { wg[j][h] = *(const f32x4*)(cw + j * DFF2 + c + 4 * h); wu[j][h] = *(const f32x4*)(cw + j * DFF2 + DFF + c + 4 * h); }
            bg[h] = *(const f32x4*)(cb + c + 4 * h); bu[h] = *(const f32x4*)(cb + DFF + c + 4 * h); }
        f32x4 g0[2], g1[2], u0[2], u1[2];
        if (!samp) {
            if ((r0 & (SEQ - 1)) == 0) {
#pragma unroll
                for (int h = 0; h < 2; ++h) g0[h] = g1[h] = u0[h] = u1[h] = (f32x4){0.f, 0.f, 0.f, 0.f};
            } else { ld8bf(A + (size_t)(r0 - 2) * DFF2 + c, g0[0], g0[1]); ld8bf(A + (size_t)(r0 - 2) * DFF2 + DFF + c, u0[0], u0[1]); ld8bf(A + (size_t)(r0 - 1) * DFF2 + c, g1[0], g1[1]); ld8bf(A + (size_t)(r0 - 1) * DFF2 + DFF + c, u1[0], u1[1]); }
        }
#pragma unroll
        for (int hb_ = 0; hb_ < 2; ++hb_) {
            u32x4 rg[8], ru[8];
#pragma unroll
            for (int i = 0; i < 8; ++i) { rg[i] = *(const u32x4*)(A + (size_t)(r0 + hb_ * 8 + i) * DFF2 + c); ru[i] = *(const u32x4*)(A + (size_t)(r0 + hb_ * 8 + i) * DFF2 + DFF + c); }
            if (samp) { const float* s = st + (size_t)((r0 - MP + hb_ * 8) >> 3) * 2 * DFF2 + c;
#pragma unroll
                for (int h = 0; h < 2; ++h) { g0[h] = *(const f32x4*)(s + 4 * h); u0[h] = *(const f32x4*)(s + DFF + 4 * h); g1[h] = *(const f32x4*)(s + DFF2 + 4 * h); u1[h] = *(const f32x4*)(s + DFF2 + DFF + 4 * h); } }
#pragma unroll
            for (int i = 0; i < 8; ++i) { f32x4 g2[2], u2[2], hh[2];
                g2[0] = (f32x4){bf2f(rg[i].x & 0xffffu), bf2f(rg[i].x >> 16), bf2f(rg[i].y & 0xffffu), bf2f(rg[i].y >> 16)}; g2[1] = (f32x4){bf2f(rg[i].z & 0xffffu), bf2f(rg[i].z >> 16), bf2f(rg[i].w & 0xffffu), bf2f(rg[i].w >> 16)};
                u2[0] = (f32x4){bf2f(ru[i].x & 0xffffu), bf2f(ru[i].x >> 16), bf2f(ru[i].y & 0xffffu), bf2f(ru[i].y >> 16)}; u2[1] = (f32x4){bf2f(ru[i].z & 0xffffu), bf2f(ru[i].z >> 16), bf2f(ru[i].w & 0xffffu), bf2f(ru[i].w >> 16)};
#pragma unroll
                for (int h = 0; h < 2; ++h) { const f32x4 cg_ = wg[0][h] * g0[h] + wg[1][h] * g1[h] + wg[2][h] * g2[h] + bg[h], cu = wu[0][h] * u0[h] + wu[1][h] * u1[h] + wu[2][h] * u2[h] + bu[h];
#pragma unroll
                    for (int e = 0; e < 4; ++e) hh[h][e] = cg_[e] * __builtin_amdgcn_rcpf(1.0f + __builtin_amdgcn_exp2f(-cg_[e] * LOG2E)) * cu[e];
                    g0[h] = g1[h]; g1[h] = g2[h]; u0[h] = u1[h]; u1[h] = u2[h]; }
                st16(HB + (size_t)(r0 + hb_ * 8 + i) * DFF + c, pack8(hh[0], hh[1])); }
        }
    }
}

constexpr int KPITCH = 144  , VPITCH = 544  , ATT_K = 0, ATT_V = 256 * KPITCH;
typedef unsigned long long u64;
__device__ __forceinline__ void attn16(const LAS unsigned char* Kl, const LAS unsigned char* Vt, const bf16x8 (&qf)[2], bf16_t* optr, int qi, int jmin, float sink2, int kw0, int fr, int fq) {
    f32x4 s[10];
#pragma unroll
    for (int kt = 0; kt < 10; ++kt) { s[kt] = (f32x4){0.f, 0.f, 0.f, 0.f};
#pragma unroll
        for (int kk = 0; kk < 2; ++kk) { const bf16x8 kf = *(const LAS bf16x8*)(Kl + (kw0 + 16 * kt + fr) * KPITCH + (32 * kk + 8 * fq) * 2); s[kt] = __builtin_amdgcn_mfma_f32_16x16x32_bf16(kf, qf[kk], s[kt], 0, 0, 0); } }
    const int lo = qi > jmin ? qi : jmin, hi = qi + 128; float mx = sink2;
#pragma unroll
    for (int kt = 0; kt < 10; ++kt)
#pragma unroll
        for (int i = 0; i < 4; ++i) { const int j = kw0 + 16 * kt + 4 * fq + i; const float v = (j >= lo && j <= hi) ? s[kt][i] : -INFINITY; s[kt][i] = v; mx = fmaxf(mx, v); }
    mx = fmaxf(mx, __shfl_xor(mx, 16)); mx = fmaxf(mx, __shfl_xor(mx, 32));
    float sum = 0.f;
#pragma unroll
    for (int kt = 0; kt < 10; ++kt)
#pragma unroll
        for (int i = 0; i < 4; ++i) { const float p = __builtin_amdgcn_exp2f(s[kt][i] - mx); s[kt][i] = p; sum += p; }
    sum += __shfl_xor(sum, 16); sum += __shfl_xor(sum, 32); sum += __builtin_amdgcn_exp2f(sink2 - mx);
    const float inv = 1.0f / sum;
    f32x4 o[4];
#pragma unroll
    for (int dt = 0; dt < 4; ++dt) o[dt] = (f32x4){0.f, 0.f, 0.f, 0.f};
#pragma unroll
    for (int sl = 0; sl < 5; ++sl) { const u32x4 pw = pack8(s[2 * sl], s[2 * sl + 1]); const bf16x8 pf = __builtin_bit_cast(bf16x8, pw);
#pragma unroll
        for (int dt = 0; dt < 4; ++dt) { const LAS unsigned char* vp = Vt + (dt * 16 + fr) * VPITCH + (kw0 + 32 * sl + 4 * fq) * 2;
            const u32x2 a = *(const LAS u32x2*)vp, b = *(const LAS u32x2*)(vp + 32); const u32x4 vw = {a.x, a.y, b.x, b.y};
            o[dt] = __builtin_amdgcn_mfma_f32_16x16x32_bf16(__builtin_bit_cast(bf16x8, vw), pf, o[dt], 0, 0, 0); } }
#pragma unroll
    for (int dt = 0; dt < 4; ++dt) { u32x2 w; w.x = cvt_pk_bf16(o[dt][0] * inv, o[dt][1] * inv); w.y = cvt_pk_bf16(o[dt][2] * inv, o[dt][3] * inv); *(u32x2*)(optr + dt * 16 + 4 * fq) = w; }
}
__device__ __forceinline__ void attn_phase(PPtr P, int la, LAS unsigned char* lds, int vcu, int G, int tid, int wave, int lane) {
    const bf16_t* Q = (const bf16_t*)(P->ws + WS_R1); const bf16_t* K = (const bf16_t*)(P->ws + WS_R1 + 34 * MiB); const bf16_t* V = (const bf16_t*)(P->ws + WS_R1 + 43 * MiB); bf16_t* O = (bf16_t*)(P->ws + WS_R1 + 52 * MiB);
    const float* sink = P->in[I_SINK] + la * 16; const int fr = lane & 15, fq = lane >> 4;
    LAS unsigned char* Kl = lds + ATT_K; LAS unsigned char* Vt = lds + ATT_V;
    const float* ck = P->in[I_CK] + (size_t)la * 128 * 128 * 256; const float* cv = P->in[I_CV] + (size_t)la * 128 * 128 * 256;
    float* oks = P->out + O_KS + (size_t)la * 128 * 128 * 256; float* ovs = P->out + O_VS + (size_t)la * 128 * 128 * 256;
#define ATT_BAR() do { asm volatile("s_waitcnt lgkmcnt(0)" ::: "memory"); __builtin_amdgcn_s_barrier(); asm volatile("" ::: "memory"); } while (0)
#define VT_SCATTER(part_, j_, vv_) do { _Pragma("unroll") for (int e = 0; e < 4; ++e) { *(LAS unsigned short*)(Vt + ((part_) * 8 + 2 * e) * VPITCH + (j_) * 2) = (unsigned short)((vv_)[e] & 0xffffu); *(LAS unsigned short*)(Vt + ((part_) * 8 + 2 * e + 1) * VPITCH + (j_) * 2) = (unsigned short)((vv_)[e] >> 16); } } while (0)
    for (int un = vcu; un < 1024; un += G) {
        if (un < 512) {
            const int b = un >> 8, g = (un >> 6) & 3, qb = un & 63; const int rbase = b * SEQ + qb * 128;
            const int qi = 16 * wave + fr, kw0 = wave < 6 ? 16 * wave : 96, jmin = qb == 0 ? 128 : 0;
            const bf16_t* qrow = Q + (size_t)(rbase + qi) * DM + 4 * g * 64 + 8 * fq;
            bf16x8 qf[2], qn[2];
#pragma unroll
            for (int kk = 0; kk < 2; ++kk) qf[kk] = *(const bf16x8*)(qrow + 32 * kk);
            const f32x4 snk = *(const f32x4*)(sink + 4 * g) * LOG2E;
            u32x4 kv[4], vv[4];
#pragma unroll
            for (int k = 0; k < 4; ++k) { const int ci = tid + 512 * k, j = ci >> 3, part = ci & 7; int row = rbase - 128 + j; if (qb == 0 && j < 128) row = rbase + j;
                kv[k] = *(const u32x4*)(K + (size_t)row * 256 + g * 64 + part * 8); vv[k] = *(const u32x4*)(V + (size_t)row * 256 + g * 64 + part * 8); }
#pragma unroll
            for (int k = 0; k < 4; ++k) { const int ci = tid + 512 * k, j = ci >> 3, part = ci & 7; *(LAS u32x4*)(Kl + j * KPITCH + part * 16) = kv[k]; VT_SCATTER(part, j, vv[k]); }
            ATT_BAR();
#pragma unroll
            for (int hh = 0; hh < 4; ++hh) { const int h = 4 * g + hh;
                if (hh < 3) {
#pragma unroll
                    for (int kk = 0; kk < 2; ++kk) qn[kk] = *(const bf16x8*)(qrow + (hh + 1) * 64 + 32 * kk); }
                attn16(Kl, Vt, qf, O + (size_t)(rbase + qi) * DM + h * 64, qi, jmin, snk[hh], kw0, fr, fq);
                qf[0] = qn[0]; qf[1] = qn[1]; }
        } else {
            const int b = (un - 512) >> 2, g = un & 3;
            const int hs = 4 * g + 2 * (wave & 1) + (fr >> 3), ts = fr & 7; const size_t ros = (size_t)(MP + b * 8 + ts) * DM + hs * 64;
            bf16x8 qf[2];
#pragma unroll
            for (int kk = 0; kk < 2; ++kk) qf[kk] = *(const bf16x8*)(Q + ros + 32 * kk + 8 * fq);
            const float snk = sink[hs] * LOG2E;
            f32x4 ck0[2], ck1[2], cv0[2], cv1[2]; u32x4 nk = {0u, 0u, 0u, 0u}, nv = nk;
#pragma unroll
            for (int it = 0; it < 2; ++it) { const int ci = tid + 512 * it, j = ci >> 3, part = ci & 7; const size_t so = ((size_t)(b * 128 + j) * 4 + g) * 64 + part * 8;
                ck0[it] = *(const f32x4*)(ck + so); ck1[it] = *(const f32x4*)(ck + so + 4); cv0[it] = *(const f32x4*)(cv + so); cv1[it] = *(const f32x4*)(cv + so + 4); }
            { const int j = 128 + (tid >> 3), part = tid & 7; if (tid < 256 && j < 136) { const size_t row = MP + b * 8 + (j - 128); nk = *(const u32x4*)(K + row * 256 + g * 64 + part * 8); nv = *(const u32x4*)(V + row * 256 + g * 64 + part * 8); } }
#pragma unroll
            for (int it = 0; it < 2; ++it) { const int ci = tid + 512 * it, j = ci >> 3, part = ci & 7;
                if (j >= 8) { const size_t d = ((size_t)(b * 128 + j - 8) * 4 + g) * 64 + part * 8; *(f32x4*)(oks + d) = ck0[it]; *(f32x4*)(oks + d + 4) = ck1[it]; *(f32x4*)(ovs + d) = cv0[it]; *(f32x4*)(ovs + d + 4) = cv1[it]; }
                *(LAS u32x4*)(Kl + j * KPITCH + part * 16) = pack8(ck0[it], ck1[it]); const u32x4 vvp = pack8(cv0[it], cv1[it]); VT_SCATTER(part, j, vvp); }
            if (tid < 256) { const int j = 128 + (tid >> 3), part = tid & 7; *(LAS u32x4*)(Kl + j * KPITCH + part * 16) = nk; VT_SCATTER(part, j, nv); }
            ATT_BAR();
            if (wave < 2) attn16(Kl, Vt, qf, O + ros, ts, 0, snk, 0, fr, fq);
        }
        ATT_BAR();
    }
#undef VT_SCATTER
#undef ATT_BAR
}

constexpr int WPITCH = 272  , MIX_W = 0, MIX_V = 128 * WPITCH;
__device__ __forceinline__ void mix_phase(PPtr P, int ls, LAS unsigned char* lds, int vcu, int G, int tid, int wave, int lane, bool dummy) {
    bf16_t* U = (bf16_t*)(P->ws + WS_R1); const bf16_t* VR = (const bf16_t*)(P->ws + WS_R1 + (size_t)M * DSGU * 2);
    const float* rstat = (const float*)(P->ws + WS_RSTAT) + (size_t)ls * M * 2; const bf16_t* wtri = (const bf16_t*)(P->ws + WS_WTRI) + (size_t)ls * 4 * 2 * 16384;
    const float* lg = P->in[I_LNG] + ls * DSGU; const float* lb = P->in[I_LNB] + ls * DSGU; float* osg = P->out + O_SG + (size_t)ls * MS * DSGU;
    const float* bsp = P->in[I_BSP] + ls * 4 * 128; const int fr = lane & 15, fq = lane >> 4;
    LAS unsigned char* Wl = lds + MIX_W; LAS unsigned char* Vb = lds + MIX_V;
    constexpr int VBUF = 128 * WPITCH, NUN = 136 * 16;
    const int part = tid & 15, sb = tid >> 4;
#define LDS_BAR() do { asm volatile("s_waitcnt lgkmcnt(0)" ::: "memory"); __builtin_amdgcn_s_barrier(); asm volatile("" ::: "memory"); } while (0)
    u32x4 raw[4]; float st0[4], st1[4]; int wvar = -1;
#define MIX_LOAD(un_) do { const int rc_ = (un_) >> 4, colb_ = (((un_) >> 2) & 3) * 512 + ((un_) & 3) * 128 + part * 8; \
        _Pragma("unroll") for (int k = 0; k < 4; ++k) { const int row_ = rc_ * 128 + sb + 32 * k; raw[k] = *(const u32x4*)(VR + (size_t)row_ * DSGU + colb_); st0[k] = rstat[2 * row_]; st1[k] = rstat[2 * row_ + 1]; } } while (0)
#define MIX_FILL(un_, Vl_) do { const int rc_ = (un_) >> 4, c0 = (((un_) >> 2) & 3) * 512 + ((un_) & 3) * 128 + part * 8; const bool samp_ = rc_ >= 128; \
        const f32x4 g0 = *(const f32x4*)(lg + c0), g1 = *(const f32x4*)(lg + c0 + 4), b0 = *(const f32x4*)(lb + c0), b1 = *(const f32x4*)(lb + c0 + 4); \
        _Pragma("unroll") for (int k = 0; k < 4; ++k) { const int s = sb + 32 * k, row = rc_ * 128 + s; const u32x4 w = raw[k]; \
            const f32x4 x0 = {bf2f(w.x & 0xffffu), bf2f(w.x >> 16), bf2f(w.y & 0xffffu), bf2f(w.y >> 16)}, x1 = {bf2f(w.z & 0xffffu), bf2f(w.z >> 16), bf2f(w.w & 0xffffu), bf2f(w.w >> 16)}; \
            const float mu = st0[k] * (1.0f / DSGU), var_ = fmaxf(st1[k] * (1.0f / DSGU) - mu * mu, 0.f), rs = 1.0f / sqrtf(var_ + EPS); \
            const f32x4 y0 = (x0 - mu) * rs * g0 + b0, y1 = (x1 - mu) * rs * g1 + b1; \
            if (samp_) { float* o = osg + (size_t)(row - MP) * DSGU + c0; *(f32x4*)o = y0; *(f32x4*)(o + 4) = y1; } \
            const u32x4 vv = pack8(y0, y1); const int so = ((((s >> 3) ^ part) << 3) + (s & 7)) * 2; \
            _Pragma("unroll") for (int e = 0; e < 4; ++e) { *(LAS unsigned short*)((Vl_) + (part * 8 + 2 * e) * WPITCH + so) = (unsigned short)(vv[e] & 0xffffu); *(LAS unsigned short*)((Vl_) + (part * 8 + 2 * e + 1) * WPITCH + so) = (unsigned short)(vv[e] >> 16); } } } while (0)
    int un = vcu, cur = 0;
    if (un < NUN) { MIX_LOAD(un); MIX_FILL(un, Vb); if (un + G < NUN) MIX_LOAD(un + G); }
    LDS_BAR();
    for (; un < NUN; un += G, cur ^= 1) {
        const int rc = un >> 4, g = (un >> 2) & 3, cs = un & 3; const bool samp = rc >= 128; const int colb = g * 512 + cs * 128;
        LAS unsigned char* Vl = Vb + cur * VBUF;
        const int var = g * 2 + (samp ? 1 : 0);
        if (var != wvar) { wvar = var; const bf16_t* wt = wtri + (size_t)var * 16384;
#pragma unroll
            for (int k = 0; k < 4; ++k) { const int ci = tid + 512 * k, t = ci >> 4, q = ci & 15; *(LAS u32x4*)(Wl + t * WPITCH + q * 16) = *(const u32x4*)(wt + t * 128 + q * 8); }
            LDS_BAR(); }
        u32x2 uws[8]; float bss[8];
#pragma unroll
        for (int tt = 0; tt < 8; ++tt) { const int t = tt * 16 + fr; uws[tt] = *(const u32x2*)(U + (size_t)(rc * 128 + t) * DSGU + colb + wave * 16 + 4 * fq); bss[tt] = bsp[g * 128 + (samp ? (t & 7) : t)]; }
        if (un + G < NUN) { MIX_FILL(un + G, Vb + (cur ^ 1) * VBUF); if (un + 2 * G < NUN) MIX_LOAD(un + 2 * G); }
        bf16x8 vf[4];
#pragma unroll
        for (int ks = 0; ks < 4; ++ks) vf[ks] = *(const LAS bf16x8*)(Vl + (wave * 16 + fr) * WPITCH + (((4 * ks + fq) ^ (wave * 2 + (fr >> 3))) << 4));
#pragma unroll
        for (int tt = 0; tt < 8; ++tt) { f32x4 acc = {0.f, 0.f, 0.f, 0.f};
#pragma unroll
            for (int ks = 0; ks < 4; ++ks) if (ks <= tt / 2) { const bf16x8 wf = *(const LAS bf16x8*)(Wl + (tt * 16 + fr) * WPITCH + (32 * ks + 8 * fq) * 2); acc = __builtin_amdgcn_mfma_f32_16x16x32_bf16(vf[ks], wf, acc, 0, 0, 0); }
            const int t = tt * 16 + fr; const float bias = bss[tt];
            bf16_t* up = U + (size_t)(rc * 128 + t) * DSGU + colb + wave * 16 + 4 * fq; const u32x2 uw = uws[tt];
            u32x2 w; w.x = cvt_pk_bf16(bf2f(uw.x & 0xffffu) * (acc[0] + bias), bf2f(uw.x >> 16) * (acc[1] + bias)); w.y = cvt_pk_bf16(bf2f(uw.y & 0xffffu) * (acc[2] + bias), bf2f(uw.y >> 16) * (acc[3] + bias));
            *(u32x2*)(dummy ? up + (size_t)68 * MiB : up) = w; }
        LDS_BAR();
    }
#undef MIX_LOAD
#undef MIX_FILL
#undef LDS_BAR
}

#define XB_TMO      128
#define XB_XCNT(j)  (256  + 64 * (j))
#define XB_XSUB(j)  (1280 + 64 * (j))
#define XB_XGEN(j)  (2304 + 64 * (j))
#define XB_TOP      3328
#define XB_TOPGEN   3392
#define XCD_BAR_WORDS 3456
#define XB_SPIN_CAP (1u << 18)

__device__ __forceinline__ unsigned xb_ld(unsigned* p)              { return __hip_atomic_load(p, __ATOMIC_RELAXED, __HIP_MEMORY_SCOPE_AGENT); }
__device__ __forceinline__ unsigned xb_add(unsigned* p, unsigned v) { return __hip_atomic_fetch_add(p, v, __ATOMIC_RELAXED, __HIP_MEMORY_SCOPE_AGENT); }
__device__ __forceinline__ unsigned xb_xcc_id() { return (unsigned)__builtin_amdgcn_s_getreg((3 << 11) | 20) & 0xFu; }
#define XB_SPIN(cond, bar) do { unsigned _sp = 0; while (cond) { __builtin_amdgcn_s_sleep(1); \
    if ((++_sp & 255u) == 0u) { if (xb_ld(&(bar)[XB_TMO])) break; if (_sp > XB_SPIN_CAP) { atomicAdd(&(bar)[XB_TMO], 1u); break; } } } } while (0)

struct XcdBarrier {
    unsigned* bar; unsigned x;
    volatile LAS unsigned* st;
};

__device__ __forceinline__ XcdBarrier xcd_barrier_post(unsigned* bar, volatile LAS unsigned* st) {
    XcdBarrier b; b.bar = bar; b.x = xb_xcc_id(); b.st = st;
    if (threadIdx.x == 0) (void)xb_add(&bar[XB_XCNT(b.x)], 1u);
    return b;
}
__device__ __forceinline__ void xcd_barrier_complete(unsigned* bar, unsigned x, unsigned& nloc, unsigned& nx) {
    const unsigned G = gridDim.x * gridDim.y * gridDim.z;
    unsigned sum, cnt, mine, sp = 0u;
    for (;;) {
        sum = 0u; cnt = 0u; mine = 0u;
#pragma unroll
        for (unsigned j = 0; j < 16; ++j) { const unsigned c = xb_ld(&bar[XB_XCNT(j)]); sum += c; cnt += (c > 0u) ? 1u : 0u; mine = (j == x) ? c : mine; }
        if (sum == G) break;
        __builtin_amdgcn_s_sleep(1);
        if ((++sp & 255u) == 0u) { if (xb_ld(&bar[XB_TMO])) break; if (sp > XB_SPIN_CAP) { atomicAdd(&bar[XB_TMO], 1u); break; } }
    }
    nloc = mine > 0u ? mine : 1u; nx = cnt > 0u ? cnt : 1u;
}

__device__ __forceinline__ void xcd_barrier(const XcdBarrier& b) {
    asm volatile("s_waitcnt vmcnt(0)" ::: "memory");
    __syncthreads();
    if (threadIdx.x == 0) {
        unsigned* bar = b.bar;
        __builtin_amdgcn_s_waitcnt(0);
        unsigned nloc = b.st[0], nx = b.st[1];
        if (nloc == 0u) { xcd_barrier_complete(bar, b.x, nloc, nx); b.st[0] = nloc; b.st[1] = nx; }
        const unsigned old = xb_add(&bar[XB_XSUB(b.x)], 1u);
        const unsigned gen = old / nloc;
        if (old + 1u == (gen + 1u) * nloc) {
            __builtin_amdgcn_fence(__ATOMIC_RELEASE, "agent");
            asm volatile("s_waitcnt vmcnt(0)" ::: "memory");
            const unsigned og = xb_add(&bar[XB_TOP], 1u);
            const unsigned tg = og / nx;
            if (og + 1u == (tg + 1u) * nx) xb_add(&bar[XB_TOPGEN], 1u);
            else XB_SPIN(xb_ld(&bar[XB_TOPGEN]) == tg, bar);
            __builtin_amdgcn_fence(__ATOMIC_ACQUIRE, "agent");
            xb_add(&bar[XB_XGEN(b.x)], 1u);
            asm volatile("s_waitcnt vmcnt(0)" ::: "memory");
        } else {
            XB_SPIN(xb_ld(&bar[XB_XGEN(b.x)]) == gen, bar);
            __builtin_amdgcn_fence(__ATOMIC_ACQUIRE, "agent");
            asm volatile("s_waitcnt vmcnt(0)" ::: "memory");
        }
    }
    __syncthreads();
}

#ifndef DBG_REP_KIND
#define DBG_REP_KIND -1
#endif
#ifndef DBG_REP_N
#define DBG_REP_N 1
#endif
#ifndef DBG_SYNC_N
#define DBG_SYNC_N 1
#endif
#ifndef DBG_MASK
#define DBG_MASK 0xffff
#endif
#define DM_(k) ((DBG_MASK >> (k)) & 1)
constexpr int N_PHASES = 39;
__device__ __forceinline__ bool phase_active(int ph) { if (ph < 2 || ph == 38) return true; const int l = (ph - 2) / 9, k = (ph - 2) % 9; return !(((l & 1) == 0 && k == 3) || ((l & 1) == 1 && k == 2)); }
__global__ void __launch_bounds__(NTHR) fwd_kernel(Params Pval) {
    PPtr P = (PPtr)__builtin_amdgcn_kernarg_segment_ptr();
    extern __shared__ __attribute__((aligned(16))) unsigned char lds_raw[];
    LAS unsigned char* lds = (LAS unsigned char*)lds_raw;
    { int t0 = threadIdx.x; for (int u = t0; u < (LDS_BYTES - 131072) / 4; u += NTHR) ((LAS unsigned*)(lds + 131072))[u] = 0u; }
    __syncthreads();
    const XcdBarrier xbar = xcd_barrier_post((unsigned*)P->ws + 4096, (volatile LAS unsigned*)(lds + 131072 + 320) + 8);
    const int ph_hi = P->ph_hi;
    for (int it = P->ph_lo * DBG_REP_N; it < ph_hi * DBG_REP_N; ++it) {
        const int ph = it / DBG_REP_N;
        if (!phase_active(ph)) continue;
        asm volatile("" : "+s"(P));
        int tid = threadIdx.x; asm volatile("" : "+v"(tid)); const int lane = tid & 63, wave = __builtin_amdgcn_readfirstlane(tid >> 6);
        int G = gridDim.x, bx = blockIdx.x; asm volatile("" : "+s"(G), "+s"(bx)); const int vcu = (G % 8 == 0) ? (bx % 8) * (G / 8) + bx / 8 : bx;
        unsigned char* ws = P->ws; float* mod = (float*)(ws + WS_MOD); const bf16_t* XN = (const bf16_t*)(ws + WS_R2);
        const int gw = vcu * NWAVES + wave, NGW = G * NWAVES;
        int kind, l = 0, li = 0, k = 0;
        if (ph == 0) kind = 0; else if (ph == 1) kind = 1; else if (ph == 38) kind = 2;
        else { l = (ph - 2) / 9; k = (ph - 2) % 9; li = l >> 1; const bool attn = (l & 1) == 0;
            kind = (k == 0 || k == 5) ? 2 : k == 1 ? (attn ? 3 : 6) : k == 2 ? (attn ? 4 : 7) : k == 3 ? 8 : (k == 4 || k == 8) ? 5 : k == 6 ? 9 : 10; }
        if (it % DBG_REP_N != 0 && !(kind == DBG_REP_KIND && ph != 38)) continue;
        if (kind == 0) { if (DM_(0)) prologue_phase(P, lds, gw, NGW, lane, wave); }
        else if (kind == 1) { if (DM_(1)) { pg8::Gemm g{(const bf16_t*)(ws + WS_SC), (const bf16_t*)(ws + WS_R1), 256, MODW, DM}; pg8::StaticOrder S; S.init(256, MODW, G, bx);
            EpiAda E{mod, P->in[I_BADA]}; pg8::gemm_phase<EpiAda, pg8::StaticOrder, true, true>(lds, g, S, E); } }
        else if (kind == 2) { if (DM_(2)) norm_phase(P, l, ph == 38 ? 2 : (k == 5 ? 1 : 0), ph == 2, ph == 2 ? 0 : (ph == 38 || k == 0) ? 11 : 8, gw, NGW, lane); }
        else if (kind == 3) { if (DM_(3)) { pg8::Gemm g{XN, (const bf16_t*)(ws + WS_WQKV) + (size_t)li * QKVN * DM, M, QKVN, DM}; pg8::StaticOrder S; S.init(M, QKVN, G, bx);
            EpiQKV E{(bf16_t*)(ws + WS_R1), (bf16_t*)(ws + WS_R1 + 34 * MiB), (bf16_t*)(ws + WS_R1 + 43 * MiB), P->in[I_BQKV] + li * QKVN, (const float*)(ws + WS_ROPE),
                     P->out + O_KP + (size_t)li * 65536, P->out + O_VP + (size_t)li * 65536, P->out + O_KS + (size_t)li * 4194304, P->out + O_VS + (size_t)li * 4194304};
            pg8::gemm_phase<EpiQKV, pg8::StaticOrder, true, true>(lds, g, S, E); } }
        else if (kind == 4) { if (DM_(4)) attn_phase(P, li, lds, vcu, G, tid, wave, lane); }
        else if (kind == 5) { if (DM_(5)) {
            const bf16_t* A; const bf16_t* Bt; int K; int part = 2;
            if (k == 8) { A = (const bf16_t*)(ws + WS_R2); Bt = (const bf16_t*)(ws + WS_WDN) + (size_t)l * DM * DFF; K = DFF; part = 5; }
            else if ((l & 1) == 0) { A = (const bf16_t*)(ws + WS_R1 + 52 * MiB); Bt = (const bf16_t*)(ws + WS_WO) + (size_t)li * DM * DM; K = DM; }
            else { A = (const bf16_t*)(ws + WS_R1); Bt = (const bf16_t*)(ws + WS_WSO) + (size_t)li * DM * DSGU; K = DSGU; }
            const int ns = K == DFF ? 11 : 8, ntk = K / 64 / ns;
            pg8::Gemm g{A, Bt, M, DM, K}; ResidOrder S; S.init(G, bx, ns, ntk);
            EpiResid E{P->out, (l == 0 && k == 4) ? P->in[I_XP] : (const float*)P->out, mod + l * 6144 + part * DM, (float*)(ws + WS_PART), ntk, (DBG_REP_KIND == 5 && DBG_REP_N > 1 && it % DBG_REP_N == 0) ? 0.f : 1.f}; pg8::gemm_phase<EpiResid, ResidOrder, true, true>(lds, g, S, E); } }
        else if (kind == 6) { if (DM_(6)) { pg8::Gemm g{XN, (const bf16_t*)(ws + WS_WSI) + (size_t)li * 2 * DSGU * DM, M, 2 * DSGU, DM}; pg8::StaticOrder S; S.init(M, 2 * DSGU, G, bx);
            EpiGelu E{(bf16_t*)(ws + WS_R1), (bf16_t*)(ws + WS_R1 + (size_t)M * DSGU * 2), P->in[I_BSI] + li * 2 * DSGU, (float*)(ws + WS_RSTAT) + (size_t)li * M * 2}; pg8::gemm_phase<EpiGelu, pg8::StaticOrder, true, true>(lds, g, S, E); } }
        else if (kind == 8) { if (DM_(8)) mix_phase(P, li, lds, vcu, G, tid, wave, lane, DBG_REP_KIND == 8 && DBG_REP_N > 1 && it % DBG_REP_N == 0); }
        else if (kind == 9) { if (DM_(9)) { pg8::Gemm g{XN, (const bf16_t*)(ws + WS_WUP) + (size_t)l * DFF2 * DM, M, DFF2, DM}; pg8::StaticOrder S; S.init(M, DFF2, G, bx);
            EpiUp E{(bf16_t*)(ws + WS_R1), P->out + O_CP + (size_t)l * 2 * 2 * DFF2, P->out + O_CS + (size_t)l * 128 * 2 * DFF2}; pg8::gemm_phase<EpiUp, pg8::StaticOrder, true, true>(lds, g, S, E); } }
        else { if (DM_(10)) conv_phase(P, l, bx * NTHR + tid, G * NTHR); }
        if (it + 1 < ph_hi * DBG_REP_N) { for (int sr = 0; sr < DBG_SYNC_N; ++sr) { if (ph_hi < 0) { __syncthreads(); cg::this_grid().sync(); } else xcd_barrier(xbar); } }
    }
}

extern "C" void kernel_launch(void* const* d_in, const int* in_sizes, int n_in, void* d_out, int out_size, void* d_ws, size_t ws_size, hipStream_t stream) {
    static int grid = 0;
    if (grid == 0) {
        if (n_in != 27 || (size_t)out_size != O_END || ws_size < WS_END) { fprintf(stderr, "kernel_launch: unexpected shapes: n_in %d out %d ws %zu\n", n_in, out_size, ws_size); grid = -1; return; }
        int dev = 0, cus = 0, per_cu = 0;
        hipGetDevice(&dev); hipDeviceGetAttribute(&cus, hipDeviceAttributeMultiprocessorCount, dev);
        if (hipFuncSetAttribute((const void*)fwd_kernel, hipFuncAttributeMaxDynamicSharedMemorySize, LDS_BYTES) != hipSuccess) { fprintf(stderr, "kernel_launch: hipFuncSetAttribute failed\n"); grid = -1; return; }
        if (hipOccupancyMaxActiveBlocksPerMultiprocessor(&per_cu, (const void*)fwd_kernel, NTHR, LDS_BYTES) != hipSuccess || per_cu < 1) { fprintf(stderr, "kernel_launch: occupancy query says %d\n", per_cu); (void)hipGetLastError(); grid = -1; return; }
        grid = cus;
    }
    if (grid < 0) return;
    Params p; memset(&p, 0, sizeof(p));
    for (int i = 0; i < 27; ++i) p.in[i] = (const float*)d_in[i];
    p.out = (float*)d_out; p.ws = (unsigned char*)d_ws;
    for (int i = 0; i < 8; ++i) p.inv[i] = pow(500000.0, -(double)i / 8.0);
#if MK_PER_PHASE
    for (int ph = 0; ph < N_PHASES; ++ph) { bool act = (ph < 2 || ph == 38) || !((((ph - 2) / 9) & 1) == 0 && (ph - 2) % 9 == 3); if (!act) continue;
        p.ph_lo = ph; p.ph_hi = ph + 1; hipLaunchKernelGGL(fwd_kernel, dim3(grid), dim3(NTHR), LDS_BYTES, stream, p); }
#else
    if (hipMemsetAsync(d_ws, 0, 65536, stream) != hipSuccess) { fprintf(stderr, "kernel_launch: memset failed\n"); return; }
    p.ph_lo = 0; p.ph_hi = N_PHASES; void* args[] = {&p};
    hipError_t e = hipLaunchCooperativeKernel((const void*)fwd_kernel, dim3(grid), dim3(NTHR), args, LDS_BYTES, stream);
    if (e != hipSuccess) fprintf(stderr, "kernel_launch: cooperative launch failed: %s (grid %d)\n", hipGetErrorString(e), grid);
#endif
}
```

```cpp
#include <hip/hip_runtime.h>
#include <hip/hip_cooperative_groups.h>
#include <cstdio>
#include <cstdint>
#include <cstring>
#include <cmath>
namespace cg = cooperative_groups;
namespace pg8 {
#define PG8_LAS __attribute__((address_space(3)))
typedef unsigned short bf16_t;
typedef short bf16x8 __attribute__((ext_vector_type(8)));
typedef float f32x4 __attribute__((ext_vector_type(4)));
typedef unsigned u32x4 __attribute__((ext_vector_type(4)));
constexpr int BM = 256, BK = 64, HALF = 128, HTB = HALF * BK * 2  , STAGE_BYTES = 8 * HTB, NXCD = 8, WGM = 8;

__host__ __device__ __forceinline__ int lds_byte(int r, int c) { const int st = (r >> 4) * 2 + (c >> 5), rr = r & 15, cc = c & 31, ob = rr * 64 + cc * 2; return st * 1024 + (ob ^ (((ob >> 9) & 1) << 5)); }
__host__ __device__ __forceinline__ void stage_rc(int b, int& R, int& C) { const int st = b / 1024, sb = b % 1024, swz = sb ^ (((sb >> 9) & 1) << 5); R = (st >> 1) * 16 + swz / 64; C = (st & 1) * 32 + (swz % 64) / 2; }
__host__ __device__ __forceinline__ int perm32(int rho) { const int n = rho >> 4, i = rho & 15; return 8 * (i >> 2) + 4 * n + (i & 3); }

struct Unit { int pm, pn, k0, nt; };
struct Gemm { const bf16_t* A; const bf16_t* Bt; int M, N, K; };

struct StaticOrder {
    int nM, nN, nwg, G, c;
    __host__ __device__ void init(int M, int N, int G_, int c_) { nM = M / BM; nN = N / BM; nwg = nM * nN; G = G_; c = c_; }
    __host__ __device__ bool next(int i, Unit& u) const {
        const long L = (long)i * G + c; if (L >= nwg) return false;
        int wgid = (int)L; { const int q = nwg / NXCD, r = nwg % NXCD, xcd = wgid % NXCD, off = wgid / NXCD; wgid = (xcd < r ? xcd * (q + 1) : r * (q + 1) + (xcd - r) * q) + off; }
        const int nig = WGM * nN, gid = wgid / nig, fm = gid * WGM, gsz = (nM - fm) < WGM ? (nM - fm) : WGM;
        u.pm = fm + ((wgid % nig) % gsz); u.pn = (wgid % nig) / gsz; u.k0 = 0; u.nt = 0; return true;
    }
    __device__ __forceinline__ void a_ready(const Unit&) const {}
    __device__ __forceinline__ void done(const Unit&) const {}
};

__device__ __forceinline__ unsigned cvt_pk_bf16(float lo, float hi) { unsigned r; asm volatile("v_cvt_pk_bf16_f32 %0, %1, %2" : "=v"(r) : "v"(lo), "v"(hi)); return r; }
typedef float f32x2 __attribute__((ext_vector_type(2)));
template <class Epi, class Sched, bool ALIGN_EPI = false, bool SP2 = false>
__device__ __forceinline__ void gemm_phase(PG8_LAS unsigned char* lds, const Gemm g, const Sched& S, const Epi& E) {
    int tid_ = threadIdx.x; asm volatile("" : "+v"(tid_));
    const int tid = tid_, wid = __builtin_amdgcn_readfirstlane(tid >> 6), lane = tid & 63, wr = wid >> 2, wc = wid & 3, fr = lane & 15, fq = lane >> 4;
    const int K = g.K, nt = K / BK;
    unsigned voffA[2], voffB[2];
#pragma unroll
    for (int i = 0; i < 2; ++i) { int R, C; stage_rc(tid * 16 + i * 8192, R, C); const int Rb = Epi::PERM ? ((R & ~31) + perm32(R & 31)) : R;
        voffA[i] = (unsigned)(R * K + C) * 2u; voffB[i] = (unsigned)(Rb * K + C) * 2u; }
    const size_t kstep = (size_t)(BK * 2);
    const size_t hstep = (size_t)HALF * K * 2;
    const size_t tstep = 2 * hstep;
    const unsigned ldsw = (unsigned)wid * 1024u;
    const int aoff = lds_byte(wr * 64 + fr, fq * 8), boff = lds_byte(wc * 32 + fr, fq * 8);
#define PG8_SA(b, h) (((b) * 2 + (h)) * HTB)
#define PG8_SB(b, h) ((4 + (b) * 2 + (h)) * HTB)
#define PG8_STAGE(bufoff, gbase, voff) do { _Pragma("unroll") for (int _i = 0; _i < 2; ++_i) \
        __builtin_amdgcn_global_load_lds((const unsigned*)((const char*)(gbase) + (voff)[_i]), (PG8_LAS unsigned*)(lds + (bufoff) + ldsw + _i * 8192), 16, 0, 0); } while (0)
#define PG8_LDA(dst, b, h) do { _Pragma("unroll") for (int m = 0; m < 4; ++m) _Pragma("unroll") for (int k = 0; k < 2; ++k) dst[m][k] = *(const PG8_LAS bf16x8*)(lds + PG8_SA(b, h) + aoff + m * 2048 + k * 1024); } while (0)
#define PG8_LDB(dst, b, h) do { _Pragma("unroll") for (int n = 0; n < 2; ++n) _Pragma("unroll") for (int k = 0; k < 2; ++k) dst[n][k] = *(const PG8_LAS bf16x8*)(lds + PG8_SB(b, h) + boff + n * 2048 + k * 1024); } while (0)
#define PG8_MMA(ai, bj, At, Bt) do { __builtin_amdgcn_s_setprio(1); _Pragma("unroll") for (int m = 0; m < 4; ++m) _Pragma("unroll") for (int n = 0; n < 2; ++n) _Pragma("unroll") for (int k = 0; k < 2; ++k) \
        acc[ai][bj][m][n] = __builtin_amdgcn_mfma_f32_16x16x32_bf16(Bt[n][k], At[m][k], acc[ai][bj][m][n], 0, 0, 0); __builtin_amdgcn_s_setprio(0); } while (0)
#define PG8_WAIT_V(n) asm volatile("s_waitcnt vmcnt(" #n ")" ::: "memory")
#define PG8_WAIT_L(n) asm volatile("s_waitcnt lgkmcnt(" #n ")" ::: "memory")
#define PG8_BAR __builtin_amdgcn_s_barrier()
#define PG8_SCHED __builtin_amdgcn_sched_barrier(0)
    Unit cur, nxt; int ui = 0;
    if (!S.next(0, cur)) return;
    f32x4 acc[2][2][4][2];
#pragma unroll
    for (int a = 0; a < 2; ++a)
#pragma unroll
        for (int b = 0; b < 2; ++b)
#pragma unroll
            for (int m = 0; m < 4; ++m)
#pragma unroll
                for (int n = 0; n < 2; ++n) acc[a][b][m][n] = (f32x4){0.f, 0.f, 0.f, 0.f};
    if constexpr (Epi::HAS_INIT) E.init(acc, cur, wr, wc, fr, fq);
    bf16x8 At[4][2], B0[2][2], B1[2][2];
    const char* cA = (const char*)g.A + (size_t)cur.pm * tstep + (size_t)cur.k0 * kstep; const char* cB = (const char*)g.Bt + (size_t)cur.pn * tstep + (size_t)cur.k0 * kstep;
    S.a_ready(cur);
    if constexpr (SP2) {
        PG8_STAGE(PG8_SB(0, 0), cB, voffB); PG8_STAGE(PG8_SB(0, 1), cB + hstep, voffB); PG8_STAGE(PG8_SA(0, 0), cA, voffA); PG8_STAGE(PG8_SA(0, 1), cA + hstep, voffA);
        if (wr == 1) PG8_BAR;
        PG8_WAIT_V(2); PG8_BAR;
        PG8_STAGE(PG8_SB(1, 0), cB + kstep, voffB); PG8_STAGE(PG8_SA(1, 0), cA + kstep, voffA); PG8_STAGE(PG8_SB(1, 1), cB + hstep + kstep, voffB);
        PG8_WAIT_V(6); PG8_BAR;
    } else {
        PG8_STAGE(PG8_SB(0, 0), cB, voffB); PG8_STAGE(PG8_SA(0, 0), cA, voffA); PG8_STAGE(PG8_SB(0, 1), cB + hstep, voffB); PG8_STAGE(PG8_SA(0, 1), cA + hstep, voffA);
        if (wr == 1) PG8_BAR;
        PG8_WAIT_V(4); PG8_BAR;
        PG8_STAGE(PG8_SB(1, 0), cB + kstep, voffB); PG8_STAGE(PG8_SA(1, 0), cA + kstep, voffA); PG8_STAGE(PG8_SB(1, 1), cB + hstep + kstep, voffB);
        PG8_WAIT_V(6); PG8_BAR;
    }
    for (;;) {
        const bool has_next = S.next(ui + 1, nxt);
        const char* nA = has_next ? (const char*)g.A + (size_t)nxt.pm * tstep + (size_t)nxt.k0 * kstep : cA; const char* nB = has_next ? (const char*)g.Bt + (size_t)nxt.pn * tstep + (size_t)nxt.k0 * kstep : cB;
        const int cnt = cur.nt ? cur.nt : nt;
        for (int t = 0; t < cnt; t += 2) {
            const bool last = (t == cnt - 2);
            const char* a1 = cA + (size_t)(t + 1) * kstep;
            const char* a2 = last ? nA : cA + (size_t)(t + 2) * kstep; const char* b2 = last ? nB : cB + (size_t)(t + 2) * kstep;
            const char* a3 = a2 + kstep; const char* b3 = b2 + kstep;
            if (last && has_next) S.a_ready(nxt);
            if constexpr (SP2) {
            PG8_LDB(B0, 0, 0); PG8_LDB(B1, 0, 1); PG8_SCHED; PG8_LDA(At, 0, 0); PG8_STAGE(PG8_SA(1, 1), a1 + hstep, voffA);
            PG8_WAIT_V(8); PG8_WAIT_L(0); PG8_BAR; PG8_MMA(0, 0, At, B0); PG8_MMA(0, 1, At, B1); PG8_BAR; PG8_SCHED;
            PG8_LDA(At, 0, 1); PG8_STAGE(PG8_SB(0, 0), b2, voffB); PG8_STAGE(PG8_SB(0, 1), b2 + hstep, voffB); PG8_STAGE(PG8_SA(0, 0), a2, voffA);
            PG8_WAIT_V(8); PG8_WAIT_L(0); PG8_BAR; PG8_MMA(1, 0, At, B0); PG8_MMA(1, 1, At, B1); PG8_BAR; PG8_SCHED;
            PG8_LDB(B0, 1, 0); PG8_LDB(B1, 1, 1); PG8_SCHED; PG8_LDA(At, 1, 0); PG8_STAGE(PG8_SA(0, 1), a2 + hstep, voffA);
            PG8_WAIT_V(8); PG8_WAIT_L(0); PG8_BAR; PG8_MMA(0, 0, At, B0); PG8_MMA(0, 1, At, B1); PG8_BAR; PG8_SCHED;
            PG8_LDA(At, 1, 1); PG8_STAGE(PG8_SB(1, 0), b3, voffB); PG8_STAGE(PG8_SB(1, 1), b3 + hstep, voffB); PG8_STAGE(PG8_SA(1, 0), a3, voffA);
            PG8_WAIT_V(8); PG8_WAIT_L(0); PG8_BAR; PG8_MMA(1, 0, At, B0); PG8_MMA(1, 1, At, B1); PG8_BAR; PG8_SCHED;
            } else {
            PG8_LDB(B0, 0, 0); PG8_SCHED; PG8_LDA(At, 0, 0); PG8_STAGE(PG8_SA(1, 1), a1 + hstep, voffA);
            PG8_WAIT_L(8); PG8_BAR; PG8_WAIT_L(0); PG8_MMA(0, 0, At, B0); PG8_BAR; PG8_SCHED;
            PG8_LDB(B1, 0, 1); PG8_STAGE(PG8_SB(0, 0), b2, voffB);
            PG8_BAR; PG8_WAIT_L(0); PG8_MMA(0, 1, At, B1); PG8_BAR;
            PG8_LDA(At, 0, 1); PG8_STAGE(PG8_SA(0, 0), a2, voffA);
            PG8_BAR; PG8_WAIT_L(0); PG8_MMA(1, 0, At, B0); PG8_BAR; PG8_SCHED;
            PG8_STAGE(PG8_SB(0, 1), b2 + hstep, voffB);
            PG8_WAIT_V(6); PG8_BAR; PG8_MMA(1, 1, At, B1); PG8_BAR;
            PG8_LDB(B0, 1, 0); PG8_SCHED; PG8_LDA(At, 1, 0); PG8_STAGE(PG8_SA(0, 1), a2 + hstep, voffA);
            PG8_WAIT_L(8); PG8_BAR; PG8_WAIT_L(0); PG8_MMA(0, 0, At, B0); PG8_BAR; PG8_SCHED;
            PG8_LDB(B1, 1, 1); PG8_STAGE(PG8_SB(1, 0), b3, voffB);
            PG8_BAR; PG8_WAIT_L(0); PG8_MMA(0, 1, At, B1); PG8_BAR;
            PG8_LDA(At, 1, 1); PG8_STAGE(PG8_SA(1, 0), a3, voffA);
            PG8_BAR; PG8_WAIT_L(0); PG8_MMA(1, 0, At, B0); PG8_BAR; PG8_SCHED;
            PG8_STAGE(PG8_SB(1, 1), b3 + hstep, voffB);
            PG8_WAIT_V(6); PG8_BAR; PG8_MMA(1, 1, At, B1); PG8_BAR;
            }
        }
        if constexpr (ALIGN_EPI) { if (wr == 0) PG8_BAR; }
        if constexpr (!Epi::AFTER_DRAIN) { E(acc, cur, wr, wc, fr, fq); S.done(cur); }
        if (!has_next) break;
#pragma unroll
        for (int a = 0; a < 2; ++a)
#pragma unroll
            for (int b = 0; b < 2; ++b)
#pragma unroll
                for (int m = 0; m < 4; ++m)
#pragma unroll
                    for (int n = 0; n < 2; ++n) acc[a][b][m][n] = (f32x4){0.f, 0.f, 0.f, 0.f};
        cur = nxt; cA = nA; cB = nB; ++ui;
        if constexpr (Epi::HAS_INIT) E.init(acc, cur, wr, wc, fr, fq);
        if constexpr (ALIGN_EPI) { if (wr == 1) PG8_BAR; }
    }
    PG8_WAIT_V(0);
    if constexpr (!ALIGN_EPI) { if (wr == 0) PG8_BAR; }
    PG8_BAR;
    if constexpr (Epi::AFTER_DRAIN) { E.fused(acc, cur, wr, wc, fr, fq, lds, wid, lane); S.done(cur); }
#undef PG8_SA
#undef PG8_SB
#undef PG8_STAGE
#undef PG8_LDA
#undef PG8_LDB
#undef PG8_MMA
#undef PG8_WAIT_V
#undef PG8_WAIT_L
#undef PG8_BAR
#undef PG8_SCHED
}
}

#ifndef MK_PER_PHASE
#define MK_PER_PHASE 0
#endif
using pg8::bf16_t; using pg8::bf16x8; using pg8::f32x4; using pg8::u32x4; using pg8::cvt_pk_bf16; using pg8::Unit;
#ifndef LAS
#define LAS __attribute__((address_space(3)))
#endif
typedef unsigned u32x2 __attribute__((ext_vector_type(2)));
constexpr int DM = 1024, MP = 16384, MS = 1024, M = MP + MS, SEQ = 8192, NSEQ = 130, DEPTH = 4;
constexpr int DFF = 2816, DFF2 = 5632, DSGU = 2048, QKVN = 1536, MODW = 6144 * DEPTH, NPOS = 8200;
constexpr float EPS = 1e-6f, LOG2E = 1.4426950408889634f, QSCALE = 0.125f * LOG2E;
constexpr int NWAVES = 8, NTHR = 512;
constexpr size_t O_Y = 0, O_KP = (size_t)M * DM, O_VP = O_KP + 131072, O_CP = O_VP + 131072, O_KS = O_CP + 90112,
                 O_VS = O_KS + 8388608, O_CS = O_VS + 8388608, O_SG = O_CS + 5767168, O_END = O_SG + 4194304;
constexpr size_t MiB = 1u << 20;
constexpr size_t WS_RSTAT = 128 * 1024  , WS_WTRI = 2 * MiB + 512 * 1024  ;
constexpr size_t WS_ROPE = 1 * MiB, WS_SC = 2 * MiB, WS_MOD = 3 * MiB, WS_WQKV = 16 * MiB, WS_WO = 22 * MiB, WS_WSI = 26 * MiB, WS_WSO = 42 * MiB,
                 WS_WUP = 50 * MiB, WS_WDN = 94 * MiB, WS_R2 = 116 * MiB, WS_R1 = 210 * MiB, WS_END = 397 * MiB;
constexpr size_t WS_PART = WS_R1 + 140 * MiB;
static_assert(WS_PART + 11 * (size_t)MS * DM * 4 <= WS_END, "partials");
static_assert(WS_R2 + (size_t)M * DFF * 2 <= WS_R1 && WS_R1 + (size_t)M * DFF2 * 2 <= WS_END && WS_MOD + (size_t)NSEQ * MODW * 4 <= WS_WQKV, "ws map");
constexpr int LDS_BYTES = 147456;

struct Params { const float* in[27]; float* out; unsigned char* ws; double inv[8]; int ph_lo, ph_hi; };
#define CAS __attribute__((address_space(4)))
typedef const CAS Params* PPtr;
enum { I_XP = 0, I_XS, I_CP, I_CS, I_CK, I_CV, I_SCONV, I_WADA, I_BADA, I_NMIX, I_NFFN, I_WQKV, I_BQKV, I_SINK, I_WO, I_WSI, I_BSI, I_LNG, I_LNB,
       I_WSP, I_BSP, I_WSO, I_WUP, I_CW, I_CB, I_WDN, I_NFIN };

__device__ __forceinline__ void row_info(int r, int& seq, int& t) { if (r < MP) { seq = r >> 13; t = r & 8191; } else { const int q = r - MP; seq = 2 + (q >> 3); t = q & 7; } }
__device__ __forceinline__ float wave_sum(float v) {
#pragma unroll
    for (int o = 1; o < 64; o <<= 1) v += __shfl_xor(v, o);
    return v;
}
__device__ __forceinline__ float bf2f(unsigned h) { return __uint_as_float(h << 16); }
__device__ __forceinline__ u32x4 pack8(const f32x4 a, const f32x4 b) { u32x4 w; w.x = cvt_pk_bf16(a[0], a[1]); w.y = cvt_pk_bf16(a[2], a[3]); w.z = cvt_pk_bf16(b[0], b[1]); w.w = cvt_pk_bf16(b[2], b[3]); return w; }

#ifndef NT_STORES
#define NT_STORES 0
#endif
__device__ __forceinline__ void st16(void* p, u32x4 v) { if (NT_STORES) __builtin_nontemporal_store(v, (u32x4*)p); else *(u32x4*)p = v; }
__device__ __forceinline__ void st8(void* p, u32x2 v) { if (NT_STORES) __builtin_nontemporal_store(v, (u32x2*)p); else *(u32x2*)p = v; }
struct EpiAda { static constexpr bool PERM = true, AFTER_DRAIN = false, HAS_INIT = false; float* mod; const float* bias;
    __device__ __forceinline__ void operator()(const f32x4 (&acc)[2][2][4][2], const Unit& u, int wr, int wc, int fr, int fq) const {
        const int row0 = u.pm * 256 + wr * 64 + fr, col0 = u.pn * 256 + wc * 32 + 8 * fq;
        f32x4 bv[2][2];
#pragma unroll
        for (int bj = 0; bj < 2; ++bj)
#pragma unroll
            for (int n = 0; n < 2; ++n) bv[bj][n] = *(const f32x4*)(bias + col0 + bj * 128 + 4 * n);
#pragma unroll
        for (int ai = 0; ai < 2; ++ai)
#pragma unroll
            for (int m = 0; m < 4; ++m) { const int r = row0 + ai * 128 + m * 16; if (r < NSEQ) {
#pragma unroll
                for (int bj = 0; bj < 2; ++bj) { float* d = mod + (size_t)r * MODW + col0 + bj * 128;
                    *(f32x4*)d = acc[ai][bj][m][0] + bv[bj][0]; *(f32x4*)(d + 4) = acc[ai][bj][m][1] + bv[bj][1]; } } }
    }
};
__device__ __forceinline__ f32x4 gate_safe(f32x4 g) { f32x4 r;
#pragma unroll
    for (int e = 0; e < 4; ++e) r[e] = __builtin_copysignf(fmaxf(fabsf(g[e]), 1e-30f), g[e]);
    return r; }
struct EpiResid { static constexpr bool PERM = false, AFTER_DRAIN = false, HAS_INIT = false;     float* x; const float* xin; const float* gate; float* part; int ntk; float gscale;
    __device__ __forceinline__ void init(f32x4 (&acc)[2][2][4][2], const Unit& u, int wr, int wc, int fr, int fq) const {
        if (u.nt) return;
        const int row0 = u.pm * 256 + wr * 64 + fr, col0 = u.pn * 256 + wc * 32 + 4 * fq;
#pragma unroll
        for (int ai = 0; ai < 2; ++ai)
#pragma unroll
            for (int m = 0; m < 4; ++m) { const int r = row0 + ai * 128 + m * 16; int seq, t; row_info(r, seq, t);
                const float* xr = x + (size_t)r * DM + col0; const float* gr = gate + (size_t)seq * MODW + col0;
#pragma unroll
                for (int bj = 0; bj < 2; ++bj)
#pragma unroll
                    for (int n = 0; n < 2; ++n) { const int o = bj * 128 + 16 * n; const f32x4 xv = *(const f32x4*)(xr + o), gv = gate_safe(*(const f32x4*)(gr + o));
#pragma unroll
                        for (int e = 0; e < 4; ++e) acc[ai][bj][m][n][e] = xv[e] * __builtin_amdgcn_rcpf(gv[e]); } }
    }
    __device__ __forceinline__ void operator()(const f32x4 (&acc)[2][2][4][2], const Unit& u, int wr, int wc, int fr, int fq) const {
        const int row0 = u.pm * 256 + wr * 64 + fr, col0 = u.pn * 256 + wc * 32 + 4 * fq;
        if (u.nt) {
#pragma unroll
            for (int ai = 0; ai < 2; ++ai) { f32x4 gq[4][2][2];
#pragma unroll
                for (int m = 0; m < 4; ++m) { const int r = row0 + ai * 128 + m * 16; int seq, t; row_info(r, seq, t); const float* gr = gate + (size_t)seq * MODW + col0;
#pragma unroll
                    for (int bj = 0; bj < 2; ++bj)
#pragma unroll
                        for (int n = 0; n < 2; ++n) gq[m][bj][n] = *(const f32x4*)(gr + bj * 128 + 16 * n); }
#pragma unroll
                for (int m = 0; m < 4; ++m) { const int r = row0 + ai * 128 + m * 16; float* pr = part + ((size_t)(u.k0 / ntk) * MS + (r - MP)) * DM + col0;
#pragma unroll
                    for (int bj = 0; bj < 2; ++bj)
#pragma unroll
                        for (int n = 0; n < 2; ++n) *(f32x4*)(pr + bj * 128 + 16 * n) = gq[m][bj][n] * gscale * acc[ai][bj][m][n]; }
                asm volatile("" ::: "memory"); }
        } else {
            int seq0, t0; row_info(u.pm * 256, seq0, t0); const float* gr = gate + (size_t)seq0 * MODW + col0;
            f32x4 gv[2][2];
#pragma unroll
            for (int bj = 0; bj < 2; ++bj)
#pragma unroll
                for (int n = 0; n < 2; ++n) gv[bj][n] = *(const f32x4*)(gr + bj * 128 + 16 * n) * gscale;
#pragma unroll
            for (int ai = 0; ai < 2; ++ai) { f32x4 xv[4][2][2];
#pragma unroll
                for (int m = 0; m < 4; ++m)
#pragma unroll
                    for (int bj = 0; bj < 2; ++bj)
#pragma unroll
                        for (int n = 0; n < 2; ++n) xv[m][bj][n] = *(const f32x4*)(xin + (size_t)(row0 + ai * 128 + m * 16) * DM + col0 + bj * 128 + 16 * n);
#pragma unroll
                for (int m = 0; m < 4; ++m)
#pragma unroll
                    for (int bj = 0; bj < 2; ++bj)
#pragma unroll
                        for (int n = 0; n < 2; ++n) *(f32x4*)(x + (size_t)(row0 + ai * 128 + m * 16) * DM + col0 + bj * 128 + 16 * n) = xv[m][bj][n] + gv[bj][n] * acc[ai][bj][m][n];
                asm volatile("" ::: "memory"); }
        }
    }
};
__device__ __forceinline__ float gelu_tanh(float x) { const float y = x * (1.0f + 0.044715f * x * x) * (1.5957691216057308f * LOG2E); return x * __builtin_amdgcn_rcpf(1.0f + __builtin_amdgcn_exp2f(-y)); }
struct EpiGelu { static constexpr bool PERM = true, AFTER_DRAIN = false, HAS_INIT = false; bf16_t* U; bf16_t* V; const float* bias; float* rstat;
    __device__ __forceinline__ void operator()(const f32x4 (&acc)[2][2][4][2], const Unit& u, int wr, int wc, int fr, int fq) const {
        const int row0 = u.pm * 256 + wr * 64 + fr, colt = u.pn * 256, col0 = colt + wc * 32 + 8 * fq;
        bf16_t* base = (colt < DSGU ? U : V) + ((col0) & (DSGU - 1));
        f32x4 bv[2][2];
#pragma unroll
        for (int bj = 0; bj < 2; ++bj)
#pragma unroll
            for (int n = 0; n < 2; ++n) bv[bj][n] = *(const f32x4*)(bias + col0 + bj * 128 + 4 * n);
#pragma unroll
        for (int ai = 0; ai < 2; ++ai)
#pragma unroll
            for (int m = 0; m < 4; ++m) { const int r = row0 + ai * 128 + m * 16; float s1 = 0.f, s2 = 0.f;
#pragma unroll
                for (int bj = 0; bj < 2; ++bj) { f32x4 v0 = acc[ai][bj][m][0] + bv[bj][0], v1 = acc[ai][bj][m][1] + bv[bj][1];
#pragma unroll
                    for (int e = 0; e < 4; ++e) { v0[e] = gelu_tanh(v0[e]); v1[e] = gelu_tanh(v1[e]); s1 += v0[e] + v1[e]; s2 += v0[e] * v0[e] + v1[e] * v1[e]; }
                    st16(base + (size_t)r * DSGU + bj * 128, pack8(v0, v1)); }
                if (colt >= DSGU) { s1 += __shfl_xor(s1, 16); s2 += __shfl_xor(s2, 16); s1 += __shfl_xor(s1, 32); s2 += __shfl_xor(s2, 32);
                    if (fq == 0) { unsafeAtomicAdd(rstat + 2 * r, s1); unsafeAtomicAdd(rstat + 2 * r + 1, s2); } } }
    }
};
struct EpiUp { static constexpr bool PERM = true, AFTER_DRAIN = false, HAS_INIT = false; bf16_t* a; float* ocp; float* ocs;
    __device__ __forceinline__ void operator()(const f32x4 (&acc)[2][2][4][2], const Unit& u, int wr, int wc, int fr, int fq) const {
        const int row0 = u.pm * 256 + wr * 64 + fr, col0 = u.pn * 256 + wc * 32 + 8 * fq;
#pragma unroll
        for (int ai = 0; ai < 2; ++ai)
#pragma unroll
            for (int m = 0; m < 4; ++m) { const int r = row0 + ai * 128 + m * 16; int seq, t; row_info(r, seq, t);
                float* tail = nullptr;
                if (r < MP) { if (t >= SEQ - 2) tail = ocp + (size_t)(seq * 2 + (t - (SEQ - 2))) * DFF2; }
                else if (t >= 6) tail = ocs + (size_t)((seq - 2) * 2 + (t - 6)) * DFF2;
#pragma unroll
                for (int bj = 0; bj < 2; ++bj) { const int c = col0 + bj * 128;
                    st16(a + (size_t)r * DFF2 + c, pack8(acc[ai][bj][m][0], acc[ai][bj][m][1]));
                    if (tail) { *(f32x4*)(tail + c) = acc[ai][bj][m][0]; *(f32x4*)(tail + c + 4) = acc[ai][bj][m][1]; } } }
    }
};
struct EpiQKV { static constexpr bool PERM = true, AFTER_DRAIN = false, HAS_INIT = false; bf16_t *Q, *K, *V; const float* bias; const float* rope; float *okp, *ovp, *oks, *ovs;
    __device__ __forceinline__ void operator()(const f32x4 (&acc)[2][2][4][2], const Unit& u, int wr, int wc, int fr, int fq) const {
        const int row0 = u.pm * 256 + wr * 64 + fr, colt = u.pn * 256, col0 = colt + wc * 32 + 8 * fq;
        const int kind = colt < 1024 ? 0 : (colt < 1280 ? 1 : 2);
        const bool do_rope = kind < 2 && (wc & 1) == 0;
        const float sgn = fq == 0 ? -1.f : 1.f;
        f32x4 bv[2][2];
#pragma unroll
        for (int bj = 0; bj < 2; ++bj)
#pragma unroll
            for (int n = 0; n < 2; ++n) bv[bj][n] = *(const f32x4*)(bias + col0 + bj * 128 + 4 * n);
        f32x4 rc0[2], rc1[2], rs0[2], rs1[2];
#pragma unroll
        for (int mm = 0; mm < 2; ++mm) { rc0[mm] = rc1[mm] = (f32x4){1.f, 1.f, 1.f, 1.f}; rs0[mm] = rs1[mm] = (f32x4){0.f, 0.f, 0.f, 0.f}; }
#pragma unroll
        for (int ai = 0; ai < 2; ++ai)
#pragma unroll
            for (int m = 0; m < 4; ++m) { const int r = row0 + ai * 128 + m * 16; int seq, t; row_info(r, seq, t);
                if ((m & 1) == 0 && do_rope && fq < 2) {
#pragma unroll
                    for (int mm = m; mm < m + 2; ++mm) { const int r_ = row0 + ai * 128 + mm * 16; int sq_, t_; row_info(r_, sq_, t_); const float* rp = rope + (size_t)(r_ < MP ? t_ : SEQ + t_) * 16;
                        rc0[mm & 1] = *(const f32x4*)rp; rc1[mm & 1] = *(const f32x4*)(rp + 4); rs0[mm & 1] = *(const f32x4*)(rp + 8) * sgn; rs1[mm & 1] = *(const f32x4*)(rp + 12) * sgn; } }
                const f32x4 c0 = rc0[m & 1], c1 = rc1[m & 1], s0 = rs0[m & 1], s1 = rs1[m & 1];
                float* tk = nullptr;
                if (kind > 0) { float* ob_p = kind == 1 ? okp : ovp; float* ob_s = kind == 1 ? oks : ovs;
                    if (r < MP) { if (t >= SEQ - 128) tk = ob_p + (size_t)(seq * 128 + (t - (SEQ - 128))) * 256; }
                    else tk = ob_s + (size_t)((seq - 2) * 128 + 120 + t) * 256; }
#pragma unroll
                for (int bj = 0; bj < 2; ++bj) { f32x4 v0 = acc[ai][bj][m][0] + bv[bj][0], v1 = acc[ai][bj][m][1] + bv[bj][1];
                    if (do_rope) { f32x4 p0, p1;
#pragma unroll
                        for (int e = 0; e < 4; ++e) { p0[e] = __shfl_xor(v0[e], 16); p1[e] = __shfl_xor(v1[e], 16); }
                        v0 = v0 * c0 + p0 * s0; v1 = v1 * c1 + p1 * s1; }
                    const int cl = (col0 & 255) + bj * 128;
                    if (kind == 0) { v0 = v0 * QSCALE; v1 = v1 * QSCALE; st16(Q + (size_t)r * DM + colt + cl, pack8(v0, v1)); }
                    else { bf16_t* dst = (kind == 1 ? K : V) + (size_t)r * 256 + cl; st16(dst, pack8(v0, v1));
                        if (tk) { *(f32x4*)(tk + cl) = v0; *(f32x4*)(tk + cl + 4) = v1; } } } }
    }
};

struct ResidOrder { pg8::StaticOrder so; int S, ntk;
    __device__ void init(int G, int c, int S_, int ntk_) { so.init(MP, DM, G, c); S = S_; ntk = ntk_; }
    __device__ bool next(int i, Unit& u) const {
        if (so.G == so.nwg) {
            const bool has_split = so.c < 16 * S;
            if (has_split && i == 0) { const int t16 = so.c / S, ks = so.c % S; u.pm = MP / 256 + (t16 >> 2); u.pn = t16 & 3; u.k0 = ks * ntk; u.nt = ntk; return true; }
            if (i == (has_split ? 1 : 0)) return so.next(0, u);
            return false; }
        const long L = (long)i * so.G + so.c;
        if (L < so.nwg) return so.next(i, u);
        const int s = (int)(L - so.nwg); if (s >= 16 * S) return false;
        const int t16 = s / S, ks = s % S; u.pm = MP / 256 + (t16 >> 2); u.pn = t16 & 3; u.k0 = ks * ntk; u.nt = ntk; return true;
    }
    __device__ __forceinline__ void a_ready(const Unit&) const {}
    __device__ __forceinline__ void done(const Unit&) const {}
};
__device__ __forceinline__ unsigned f2bf(float f) { unsigned u = __builtin_bit_cast(unsigned, f); return (u + 0x7fffu + ((u >> 16) & 1u)) >> 16; }
__device__ __forceinline__ unsigned pk2(float lo, float hi) { return f2bf(lo) | (f2bf(hi) << 16); }
struct TItem { const float* src; bf16_t* dst; int K, N; };
__device__ __forceinline__ void titem_load(const TItem& t, f32x4 (&v)[8], int lane) {
#pragma unroll
    for (int i = 0; i < 8; ++i) v[i] = *(const f32x4*)(t.src + (size_t)(4 * i + (lane >> 4)) * t.N + (lane & 15) * 4);
}
__device__ __forceinline__ void titem_store(const TItem& t, const f32x4 (&v)[8], LAS float* scr, int lane) {
#pragma unroll
    for (int i = 0; i < 8; ++i) { LAS float* s = scr + (4 * i + (lane >> 4)) * 65 + (lane & 15) * 4; s[0] = v[i][0]; s[1] = v[i][1]; s[2] = v[i][2]; s[3] = v[i][3]; }
    asm volatile("s_waitcnt lgkmcnt(0)" ::: "memory");
#pragma unroll
    for (int j = 0; j < 4; ++j) { const int id = lane + 64 * j, n = id >> 2, c = id & 3; const LAS float* s = scr + (8 * c) * 65 + n;
        u32x4 o; o.x = pk2(s[0 * 65], s[1 * 65]); o.y = pk2(s[2 * 65], s[3 * 65]); o.z = pk2(s[4 * 65], s[5 * 65]); o.w = pk2(s[6 * 65], s[7 * 65]);
        *(u32x4*)(t.dst + (size_t)n * t.K + 8 * c) = o; }
    asm volatile("s_waitcnt lgkmcnt(0)" ::: "memory");
}
__device__ __forceinline__ void prologue_phase(PPtr P, LAS unsigned char* lds, int gw, int NGW, int lane, int wave) {
    LAS float* scr = (LAS float*)(lds + wave * 16384);
    unsigned char* ws = P->ws;
    constexpr int NMAT = 7;
    const int   mi[NMAT] = {I_WADA, I_WQKV, I_WO, I_WSI, I_WSO, I_WUP, I_WDN};
    const int   mk[NMAT] = {DM, DM, DM, DM, DSGU, DM, DFF};
    const int   mn[NMAT] = {6144, QKVN, DM, 2 * DSGU, DM, DFF2, DM};
    const int   ml[NMAT] = {4, 2, 2, 2, 2, 4, 4};
    const size_t mo[NMAT] = {WS_R1, WS_WQKV, WS_WO, WS_WSI, WS_WSO, WS_WUP, WS_WDN};
    int total = 0;
#pragma unroll
    for (int i = 0; i < NMAT; ++i) total += ml[i] * (mk[i] / 32) * (mn[i] / 64);
#define TITEM_DECODE(it_, T_) do { int r_ = (it_); \
        _Pragma("unroll") for (int i = 0; i < NMAT; ++i) { const int per = (mk[i] / 32) * (mn[i] / 64), cnt = ml[i] * per; \
            if (r_ >= 0 && r_ < cnt) { const int l_ = r_ / per, li_ = r_ % per, nblk = mn[i] / 64, kb = li_ / nblk, nb = li_ % nblk; const size_t mat = (size_t)mk[i] * mn[i]; \
                T_.src = P->in[mi[i]] + (size_t)l_ * mat + (size_t)(32 * kb) * mn[i] + 64 * nb; T_.dst = (bf16_t*)(ws + mo[i]) + (size_t)l_ * mat + (size_t)(64 * nb) * mk[i] + 32 * kb; T_.K = mk[i]; T_.N = mn[i]; r_ = -1; } \
            else if (r_ >= 0) r_ -= cnt; } } while (0)
    for (int it = gw; it < total; it += 2 * NGW) {
        TItem ta, tb; f32x4 va[8], vb[8]; const bool two = it + NGW < total;
        TITEM_DECODE(it, ta); titem_load(ta, va, lane);
        if (two) { TITEM_DECODE(it + NGW, tb); titem_load(tb, vb, lane); }
        titem_store(ta, va, scr, lane);
        if (two) titem_store(tb, vb, scr, lane);
    }
#undef TITEM_DECODE
    const int gt = gw * 64 + lane, NGT = NGW * 64;
    float* rope = (float*)(ws + WS_ROPE);
    for (int i = gt; i < NPOS * 8; i += NGT) { const int pos = i >> 3, k = i & 7; const double rev = (double)pos * P->inv[k] * 0.15915494309189535; const float fr = (float)(rev - floor(rev));
        rope[pos * 16 + k] = __builtin_amdgcn_cosf(fr); rope[pos * 16 + 8 + k] = __builtin_amdgcn_sinf(fr); }
    float* rst = (float*)(ws + WS_RSTAT);
    for (int i = gt; i < 2 * M * 2; i += NGT) rst[i] = 0.f;
    bf16_t* wtri = (bf16_t*)(ws + WS_WTRI);
    for (int i = gt; i < 2 * 4 * 2 * 16384; i += NGT) { const int s = i & 127, t = (i >> 7) & 127, var = (i >> 14) & 1, lg = i >> 15; const float* w = P->in[I_WSP] + (size_t)lg * 16384; float v;
        if (var == 0) v = s <= t ? w[t * 128 + s] : 0.f; else v = ((s >> 3) == (t >> 3) && (s & 7) <= (t & 7)) ? w[(t & 7) * 128 + (s & 7)] : 0.f;
        wtri[i] = (bf16_t)f2bf(v); }
    bf16_t* SC = (bf16_t*)(ws + WS_SC);
    for (int i = gt; i < 256 * DM; i += NGT) { const int s = i >> 10, k = i & 1023; float v = 0.f;
        if (s < NSEQ) { const float c = s < 2 ? P->in[I_CP][s * DM + k] : P->in[I_CS][(s - 2) * DM + k]; v = c / (1.0f + __expf(-c)); }
        SC[i] = (bf16_t)f2bf(v); }
}
__device__ __forceinline__ void norm_phase(PPtr P, int l, int mode, bool first, int nsplit, int gw, int NGW, int lane) {
    float* xbuf = P->out; bf16_t* XN = (bf16_t*)(P->ws + WS_R2); const float* mod = (const float*)(P->ws + WS_MOD);
    const float* gw_ = mode == 2 ? P->in[I_NFIN] : (mode == 0 ? P->in[I_NMIX] : P->in[I_NFFN]) + l * DM;
    f32x4 g[4];
#pragma unroll
    for (int j = 0; j < 4; ++j) g[j] = ((const f32x4*)gw_)[lane + 64 * j];
    for (int r = MP + gw; r < M; r += NGW) {
        const float* src = first ? P->in[I_XS] + (size_t)(r - MP) * DM : xbuf + (size_t)r * DM;
        f32x4 v[4], shs[4], scs[4];
#pragma unroll
        for (int j = 0; j < 4; ++j) v[j] = ((const f32x4*)src)[lane + 64 * j];
        if (mode != 2) { int seq, t; row_info(r, seq, t); const float* mr = mod + (size_t)seq * MODW + l * 6144 + (mode ? 3 * DM : 0);
#pragma unroll
            for (int j = 0; j < 4; ++j) { shs[j] = ((const f32x4*)mr)[lane + 64 * j]; scs[j] = ((const f32x4*)(mr + DM))[lane + 64 * j]; } }
        if (nsplit > 0) { const float* pp = (const float*)(P->ws + WS_PART) + (size_t)(r - MP) * DM;
#pragma unroll
            for (int bt = 0; bt < 4; ++bt) { f32x4 pv[3][4];
#pragma unroll
                for (int s = 0; s < 3; ++s) if (bt * 3 + s < nsplit) {
#pragma unroll
                    for (int j = 0; j < 4; ++j) pv[s][j] = ((const f32x4*)(pp + (size_t)(bt * 3 + s) * MS * DM))[lane + 64 * j]; }
#pragma unroll
                for (int s = 0; s < 3; ++s) if (bt * 3 + s < nsplit) {
#pragma unroll
                    for (int j = 0; j < 4; ++j) v[j] += pv[s][j]; }
                asm volatile("" ::: "memory"); } }
        float ss = 0.f;
#pragma unroll
        for (int j = 0; j < 4; ++j) ss += (v[j][0] * v[j][0] + v[j][1] * v[j][1]) + (v[j][2] * v[j][2] + v[j][3] * v[j][3]);
        const float rs = 1.0f / sqrtf(wave_sum(ss) * (1.0f / DM) + EPS);
        if (mode == 2) {
#pragma unroll
            for (int j = 0; j < 4; ++j) ((f32x4*)(xbuf + (size_t)r * DM))[lane + 64 * j] = v[j] * rs * g[j];
        } else {
#pragma unroll
            for (int j = 0; j < 4; ++j) { const f32x4 sh = shs[j], sc = scs[j];
                const f32x4 h = v[j] * rs * g[j] * (sc + 1.0f) + sh; u32x2 w; w.x = cvt_pk_bf16(h[0], h[1]); w.y = cvt_pk_bf16(h[2], h[3]);
                st8((u32x2*)(XN + (size_t)r * DM) + lane + 64 * j, w);
                if (first || nsplit > 0) ((f32x4*)(xbuf + (size_t)r * DM))[lane + 64 * j] = v[j]; } }
    }
    int base = gw, stride = NGW, nk = (MP - gw + NGW - 1) / NGW;
    if (NGW == 2 * MS && MP == 8 * NGW) { stride = MS; if (gw < MS) { base = gw; nk = 6; } else { base = 6 * MS + (gw - MS); nk = 10; } }
    for (int k = 0; k < nk; k += 2) {
        const int r0 = base + stride * k, r1 = r0 + stride; const bool has1 = k + 1 < nk;
        f32x4 v[2][4], sh[2][4], sc[2][4];
#pragma unroll
        for (int q = 0; q < 2; ++q) { const int r = q ? r1 : r0; if (q == 0 || has1) {
            const float* src = first ? P->in[I_XP] + (size_t)r * DM : xbuf + (size_t)r * DM;
#pragma unroll
            for (int j = 0; j < 4; ++j) v[q][j] = ((const f32x4*)src)[lane + 64 * j];
            if (mode != 2) { const float* mr = mod + (size_t)(r >> 13) * MODW + l * 6144 + (mode ? 3 * DM : 0);
#pragma unroll
                for (int j = 0; j < 4; ++j) { sh[q][j] = ((const f32x4*)mr)[lane + 64 * j]; sc[q][j] = ((const f32x4*)(mr + DM))[lane + 64 * j]; } } } }
        float ss[2] = {0.f, 0.f};
#pragma unroll
        for (int q = 0; q < 2; ++q) if (q == 0 || has1) {
#pragma unroll
            for (int j = 0; j < 4; ++j) ss[q] += (v[q][j][0] * v[q][j][0] + v[q][j][1] * v[q][j][1]) + (v[q][j][2] * v[q][j][2] + v[q][j][3] * v[q][j][3]); }
        ss[0] = wave_sum(ss[0]); if (has1) ss[1] = wave_sum(ss[1]);
#pragma unroll
        for (int q = 0; q < 2; ++q) { const int r = q ? r1 : r0; if (q == 0 || has1) {
            const float rs = 1.0f / sqrtf(ss[q] * (1.0f / DM) + EPS);
            if (mode == 2) {
#pragma unroll
                for (int j = 0; j < 4; ++j) ((f32x4*)(xbuf + (size_t)r * DM))[lane + 64 * j] = v[q][j] * rs * g[j];
            } else {
#pragma unroll
                for (int j = 0; j < 4; ++j) { const f32x4 h = v[q][j] * rs * g[j] * (sc[q][j] + 1.0f) + sh[q][j]; u32x2 w; w.x = cvt_pk_bf16(h[0], h[1]); w.y = cvt_pk_bf16(h[2], h[3]);
                    st8((u32x2*)(XN + (size_t)r * DM) + lane + 64 * j, w);
                    }
            } } }
    }
}
__device__ __forceinline__ void ld8bf(const bf16_t* p, f32x4& lo, f32x4& hi) { const u32x4 w = *(const u32x4*)p; lo = (f32x4){bf2f(w.x & 0xffffu), bf2f(w.x >> 16), bf2f(w.y & 0xffffu), bf2f(w.y >> 16)}; hi = (f32x4){bf2f(w.z & 0xffffu), bf2f(w.z >> 16), bf2f(w.w & 0xffffu), bf2f(w.w >> 16)}; }
__device__ __forceinline__ void conv_phase(PPtr P, int l, int gtid, int NGT) {
    const bf16_t* A = (const bf16_t*)(P->ws + WS_R1); bf16_t* HB = (bf16_t*)(P->ws + WS_R2);
    const float* cw = P->in[I_CW] + (size_t)l * 3 * DFF2; const float* cb = P->in[I_CB] + (size_t)l * DFF2; const float* st = P->in[I_SCONV] + (size_t)l * 128 * 2 * DFF2;
    constexpr int NCG = DFF / 8, NITEM = (M / 16) * NCG;
    for (int it = gtid; it < NITEM; it += NGT) {
        const int seg = it / NCG, c = (it % NCG) * 8, r0 = seg * 16; const bool samp = r0 >= MP;
        f32x4 wg[3][2], wu[3][2], bg[2], bu[2];
#pragma unroll
        for (int h = 0; h < 2; ++h) {
#pragma unroll
            for (int j = 0; j < 3; ++j) { wg[j][h] = *(const f32x4*)(cw + j * DFF2 + c + 4 * h); wu[j][h] = *(const f32x4*)(cw + j * DFF2 + DFF + c + 4 * h); }
            bg[h] = *(const f32x4*)(cb + c + 4 * h); bu[h] = *(const f32x4*)(cb + DFF + c + 4 * h); }
        f32x4 g0[2], g1[2], u0[2], u1[2];
        if (!samp) {
            if ((r0 & (SEQ - 1)) == 0) {
#pragma unroll
                for (int h = 0; h < 2; ++h) g0[h] = g1[h] = u0[h] = u1[h] = (f32x4){0.f, 0.f, 0.f, 0.f};
            } else { ld8bf(A + (size_t)(r0 - 2) * DFF2 + c, g0[0], g0[1]); ld8bf(A + (size_t)(r0 - 2) * DFF2 + DFF + c, u0[0], u0[1]); ld8bf(A + (size_t)(r0 - 1) * DFF2 + c, g1[0], g1[1]); ld8bf(A + (size_t)(r0 - 1) * DFF2 + DFF + c, u1[0], u1[1]); }
        }
#pragma unroll
        for (int hb_ = 0; hb_ < 2; ++hb_) {
            u32x4 rg[8], ru[8];
#pragma unroll
            for (int i = 0; i < 8; ++i) { rg[i] = *(const u32x4*)(A + (size_t)(r0 + hb_ * 8 + i) * DFF2 + c); ru[i] = *(const u32x4*)(A + (size_t)(r0 + hb_ * 8 + i) * DFF2 + DFF + c); }
            if (samp) { const float* s = st + (size_t)((r0 - MP + hb_ * 8) >> 3) * 2 * DFF2 + c;
#pragma unroll
                for (int h = 0; h < 2; ++h) { g0[h] = *(const f32x4*)(s + 4 * h); u0[h] = *(const f32x4*)(s + DFF + 4 * h); g1[h] = *(const f32x4*)(s + DFF2 + 4 * h); u1[h] = *(const f32x4*)(s + DFF2 + DFF + 4 * h); } }
#pragma unroll
            for (int i = 0; i < 8; ++i) { f32x4 g2[2], u2[2], hh[2];
                g2[0] = (f32x4){bf2f(rg[i].x & 0xffffu), bf2f(rg[i].x >> 16), bf2f(rg[i].y & 0xffffu), bf2f(rg[i].y >> 16)}; g2[1] = (f32x4){bf2f(rg[i].z & 0xffffu), bf2f(rg[i].z >> 16), bf2f(rg[i].w & 0xffffu), bf2f(rg[i].w >> 16)};
                u2[0] = (f32x4){bf2f(ru[i].x & 0xffffu), bf2f(ru[i].x >> 16), bf2f(ru[i].y & 0xffffu), bf2f(ru[i].y >> 16)}; u2[1] = (f32x4){bf2f(ru[i].z & 0xffffu), bf2f(ru[i].z >> 16), bf2f(ru[i].w & 0xffffu), bf2f(ru[i].w >> 16)};
#pragma unroll
                for (int h = 0; h < 2; ++h) { const f32x4 cg_ = wg[0][h] * g0[h] + wg[1][h] * g1[h] + wg[2][h] * g2[h] + bg[h], cu = wu[0][h] * u0[h] + wu[1][h] * u1[h] + wu[2][h] * u2[h] + bu[h];
#pragma unroll
                    for (int e = 0; e < 4; ++e) hh[h][e] = cg_[e] * __builtin_amdgcn_rcpf(1.0f + __builtin_amdgcn_exp2f(-cg_[e] * LOG2E)) * cu[e];
                    g0[h] = g1[h]; g1[h] = g2[h]; u0[h] = u1[h]; u1[h] = u2[h]; }
                st16(HB + (size_t)(r0 + hb_ * 8 + i) * DFF + c, pack8(hh[0], hh[1])); }
        }
    }
}

constexpr int KPITCH = 144  , VPITCH = 544  , ATT_K = 0, ATT_V = 256 * KPITCH;
typedef unsigned long long u64;
__device__ __forceinline__ void attn16(const LAS unsigned char* Kl, const LAS unsigned char* Vt, const bf16x8 (&qf)[2], bf16_t* optr, int qi, int jmin, float sink2, int kw0, int fr, int fq) {
    f32x4 s[10];
#pragma unroll
    for (int kt = 0; kt < 10; ++kt) { s[kt] = (f32x4){0.f, 0.f, 0.f, 0.f};
#pragma unroll
        for (int kk = 0; kk < 2; ++kk) { const bf16x8 kf = *(const LAS bf16x8*)(Kl + (kw0 + 16 * kt + fr) * KPITCH + (32 * kk + 8 * fq) * 2); s[kt] = __builtin_amdgcn_mfma_f32_16x16x32_bf16(kf, qf[kk], s[kt], 0, 0, 0); } }
    const int lo = qi > jmin ? qi : jmin, hi = qi + 128; float mx = sink2;
#pragma unroll
    for (int kt = 0; kt < 10; ++kt)
#pragma unroll
        for (int i = 0; i < 4; ++i) { const int j = kw0 + 16 * kt + 4 * fq + i; const float v = (j >= lo && j <= hi) ? s[kt][i] : -INFINITY; s[kt][i] = v; mx = fmaxf(mx, v); }
    mx = fmaxf(mx, __shfl_xor(mx, 16)); mx = fmaxf(mx, __shfl_xor(mx, 32));
    float sum = 0.f;
#pragma unroll
    for (int kt = 0; kt < 10; ++kt)
#pragma unroll
        for (int i = 0; i < 4; ++i) { const float p = __builtin_amdgcn_exp2f(s[kt][i] - mx); s[kt][i] = p; sum += p; }
    sum += __shfl_xor(sum, 16); sum += __shfl_xor(sum, 32); sum += __builtin_amdgcn_exp2f(sink2 - mx);
    const float inv = 1.0f / sum;
    f32x4 o[4];
#pragma unroll
    for (int dt = 0; dt < 4; ++dt) o[dt] = (f32x4){0.f, 0.f, 0.f, 0.f};
#pragma unroll
    for (int sl = 0; sl < 5; ++sl) { const u32x4 pw = pack8(s[2 * sl], s[2 * sl + 1]); const bf16x8 pf = __builtin_bit_cast(bf16x8, pw);
#pragma unroll
        for (int dt = 0; dt < 4; ++dt) { const LAS unsigned char* vp = Vt + (dt * 16 + fr) * VPITCH + (kw0 + 32 * sl + 4 * fq) * 2;
            const u32x2 a = *(const LAS u32x2*)vp, b = *(const LAS u32x2*)(vp + 32); const u32x4 vw = {a.x, a.y, b.x, b.y};
            o[dt] = __builtin_amdgcn_mfma_f32_16x16x32_bf16(__builtin_bit_cast(bf16x8, vw), pf, o[dt], 0, 0, 0); } }
#pragma unroll
    for (int dt = 0; dt < 4; ++dt) { u32x2 w; w.x = cvt_pk_bf16(o[dt][0] * inv, o[dt][1] * inv); w.y = cvt_pk_bf16(o[dt][2] * inv, o[dt][3] * inv); *(u32x2*)(optr + dt * 16 + 4 * fq) = w; }
}
__device__ __forceinline__ void attn_phase(PPtr P, int la, LAS unsigned char* lds, int vcu, int G, int tid, int wave, int lane) {
    const bf16_t* Q = (const bf16_t*)(P->ws + WS_R1); const bf16_t* K = (const bf16_t*)(P->ws + WS_R1 + 34 * MiB); const bf16_t* V = (const bf16_t*)(P->ws + WS_R1 + 43 * MiB); bf16_t* O = (bf16_t*)(P->ws + WS_R1 + 52 * MiB);
    const float* sink = P->in[I_SINK] + la * 16; const int fr = lane & 15, fq = lane >> 4;
    LAS unsigned char* Kl = lds + ATT_K; LAS unsigned char* Vt = lds + ATT_V;
    const float* ck = P->in[I_CK] + (size_t)la * 128 * 128 * 256; const float* cv = P->in[I_CV] + (size_t)la * 128 * 128 * 256;
    float* oks = P->out + O_KS + (size_t)la * 128 * 128 * 256; float* ovs = P->out + O_VS + (size_t)la * 128 * 128 * 256;
#define ATT_BAR() do { asm volatile("s_waitcnt lgkmcnt(0)" ::: "memory"); __builtin_amdgcn_s_barrier(); asm volatile("" ::: "memory"); } while (0)
#define VT_SCATTER(part_, j_, vv_) do { _Pragma("unroll") for (int e = 0; e < 4; ++e) { *(LAS unsigned short*)(Vt + ((part_) * 8 + 2 * e) * VPITCH + (j_) * 2) = (unsigned short)((vv_)[e] & 0xffffu); *(LAS unsigned short*)(Vt + ((part_) * 8 + 2 * e + 1) * VPITCH + (j_) * 2) = (unsigned short)((vv_)[e] >> 16); } } while (0)
    for (int un = vcu; un < 1024; un += G) {
        if (un < 512) {
            const int b = un >> 8, g = (un >> 6) & 3, qb = un & 63; const int rbase = b * SEQ + qb * 128;
            const int qi = 16 * wave + fr, kw0 = wave < 6 ? 16 * wave : 96, jmin = qb == 0 ? 128 : 0;
            const bf16_t* qrow = Q + (size_t)(rbase + qi) * DM + 4 * g * 64 + 8 * fq;
            bf16x8 qf[2], qn[2];
#pragma unroll
            for (int kk = 0; kk < 2; ++kk) qf[kk] = *(const bf16x8*)(qrow + 32 * kk);
            const f32x4 snk = *(const f32x4*)(sink + 4 * g) * LOG2E;
            u32x4 kv[4], vv[4];
#pragma unroll
            for (int k = 0; k < 4; ++k) { const int ci = tid + 512 * k, j = ci >> 3, part = ci & 7; int row = rbase - 128 + j; if (qb == 0 && j < 128) row = rbase + j;
                kv[k] = *(const u32x4*)(K + (size_t)row * 256 + g * 64 + part * 8); vv[k] = *(const u32x4*)(V + (size_t)row * 256 + g * 64 + part * 8); }
#pragma unroll
            for (int k = 0; k < 4; ++k) { const int ci = tid + 512 * k, j = ci >> 3, part = ci & 7; *(LAS u32x4*)(Kl + j * KPITCH + part * 16) = kv[k]; VT_SCATTER(part, j, vv[k]); }
            ATT_BAR();
#pragma unroll
            for (int hh = 0; hh < 4; ++hh) { const int h = 4 * g + hh;
                if (hh < 3) {
#pragma unroll
                    for (int kk = 0; kk < 2; ++kk) qn[kk] = *(const bf16x8*)(qrow + (hh + 1) * 64 + 32 * kk); }
                attn16(Kl, Vt, qf, O + (size_t)(rbase + qi) * DM + h * 64, qi, jmin, snk[hh], kw0, fr, fq);
                qf[0] = qn[0]; qf[1] = qn[1]; }
        } else {
            const int b = (un - 512) >> 2, g = un & 3;
            const int hs = 4 * g + 2 * (wave & 1) + (fr >> 3), ts = fr & 7; const size_t ros = (size_t)(MP + b * 8 + ts) * DM + hs * 64;
            bf16x8 qf[2];
#pragma unroll
            for (int kk = 0; kk < 2; ++kk) qf[kk] = *(const bf16x8*)(Q + ros + 32 * kk + 8 * fq);
            const float snk = sink[hs] * LOG2E;
            f32x4 ck0[2], ck1[2], cv0[2], cv1[2]; u32x4 nk = {0u, 0u, 0u, 0u}, nv = nk;
#pragma unroll
            for (int it = 0; it < 2; ++it) { const int ci = tid + 512 * it, j = ci >> 3, part = ci & 7; const size_t so = ((size_t)(b * 128 + j) * 4 + g) * 64 + part * 8;
                ck0[it] = *(const f32x4*)(ck + so); ck1[it] = *(const f32x4*)(ck + so + 4); cv0[it] = *(const f32x4*)(cv + so); cv1[it] = *(const f32x4*)(cv + so + 4); }
            { const int j = 128 + (tid >> 3), part = tid & 7; if (tid < 256 && j < 136) { const size_t row = MP + b * 8 + (j - 128); nk = *(const u32x4*)(K + row * 256 + g * 64 + part * 8); nv = *(const u32x4*)(V + row * 256 + g * 64 + part * 8); } }
#pragma unroll
            for (int it = 0; it < 2; ++it) { const int ci = tid + 512 * it, j = ci >> 3, part = ci & 7;
                if (j >= 8) { const size_t d = ((size_t)(b * 128 + j - 8) * 4 + g) * 64 + part * 8; *(f32x4*)(oks + d) = ck0[it]; *(f32x4*)(oks + d + 4) = ck1[it]; *(f32x4*)(ovs + d) = cv0[it]; *(f32x4*)(ovs + d + 4) = cv1[it]; }
                *(LAS u32x4*)(Kl + j * KPITCH + part * 16) = pack8(ck0[it], ck1[it]); const u32x4 vvp = pack8(cv0[it], cv1[it]); VT_SCATTER(part, j, vvp); }
            if (tid < 256) { const int j = 128 + (tid >> 3), part = tid & 7; *(LAS u32x4*)(Kl + j * KPITCH + part * 16) = nk; VT_SCATTER(part, j, nv); }
            ATT_BAR();
            if (wave < 2) attn16(Kl, Vt, qf, O + ros, ts, 0, snk, 0, fr, fq);
        }
        ATT_BAR();
    }
#undef VT_SCATTER
#undef ATT_BAR
}

constexpr int WPITCH = 272  , MIX_W = 0, MIX_V = 128 * WPITCH;
__device__ __forceinline__ void mix_phase(PPtr P, int ls, LAS unsigned char* lds, int vcu, int G, int tid, int wave, int lane, bool dummy) {
    bf16_t* U = (bf16_t*)(P->ws + WS_R1); const bf16_t* VR = (const bf16_t*)(P->ws + WS_R1 + (size_t)M * DSGU * 2);
    const float* rstat = (const float*)(P->ws + WS_RSTAT) + (size_t)ls * M * 2; const bf16_t* wtri = (const bf16_t*)(P->ws + WS_WTRI) + (size_t)ls * 4 * 2 * 16384;
    const float* lg = P->in[I_LNG] + ls * DSGU; const float* lb = P->in[I_LNB] + ls * DSGU; float* osg = P->out + O_SG + (size_t)ls * MS * DSGU;
    const float* bsp = P->in[I_BSP] + ls * 4 * 128; const int fr = lane & 15, fq = lane >> 4;
    LAS unsigned char* Wl = lds + MIX_W; LAS unsigned char* Vb = lds + MIX_V;
    constexpr int VBUF = 128 * WPITCH, NUN = 136 * 16;
    const int part = tid & 15, sb = tid >> 4;
#define LDS_BAR() do { asm volatile("s_waitcnt lgkmcnt(0)" ::: "memory"); __builtin_amdgcn_s_barrier(); asm volatile("" ::: "memory"); } while (0)
    u32x4 raw[4]; float st0[4], st1[4]; int wvar = -1;
#define MIX_LOAD(un_) do { const int rc_ = (un_) >> 4, colb_ = (((un_) >> 2) & 3) * 512 + ((un_) & 3) * 128 + part * 8; \
        _Pragma("unroll") for (int k = 0; k < 4; ++k) { const int row_ = rc_ * 128 + sb + 32 * k; raw[k] = *(const u32x4*)(VR + (size_t)row_ * DSGU + colb_); st0[k] = rstat[2 * row_]; st1[k] = rstat[2 * row_ + 1]; } } while (0)
#define MIX_FILL(un_, Vl_) do { const int rc_ = (un_) >> 4, c0 = (((un_) >> 2) & 3) * 512 + ((un_) & 3) * 128 + part * 8; const bool samp_ = rc_ >= 128; \
        const f32x4 g0 = *(const f32x4*)(lg + c0), g1 = *(const f32x4*)(lg + c0 + 4), b0 = *(const f32x4*)(lb + c0), b1 = *(const f32x4*)(lb + c0 + 4); \
        _Pragma("unroll") for (int k = 0; k < 4; ++k) { const int s = sb + 32 * k, row = rc_ * 128 + s; const u32x4 w = raw[k]; \
            const f32x4 x0 = {bf2f(w.x & 0xffffu), bf2f(w.x >> 16), bf2f(w.y & 0xffffu), bf2f(w.y >> 16)}, x1 = {bf2f(w.z & 0xffffu), bf2f(w.z >> 16), bf2f(w.w & 0xffffu), bf2f(w.w >> 16)}; \
            const float mu = st0[k] * (1.0f / DSGU), var_ = fmaxf(st1[k] * (1.0f / DSGU) - mu * mu, 0.f), rs = 1.0f / sqrtf(var_ + EPS); \
            const f32x4 y0 = (x0 - mu) * rs * g0 + b0, y1 = (x1 - mu) * rs * g1 + b1; \
            if (samp_) { float* o = osg + (size_t)(row - MP) * DSGU + c0; *(f32x4*)o = y0; *(f32x4*)(o + 4) = y1; } \
            const u32x4 vv = pack8(y0, y1); const int so = ((((s >> 3) ^ part) << 3) + (s & 7)) * 2; \
            _Pragma("unroll") for (int e = 0; e < 4; ++e) { *(LAS unsigned short*)((Vl_) + (part * 8 + 2 * e) * WPITCH + so) = (unsigned short)(vv[e] & 0xffffu); *(LAS unsigned short*)((Vl_) + (part * 8 + 2 * e + 1) * WPITCH + so) = (unsigned short)(vv[e] >> 16); } } } while (0)
    int un = vcu, cur = 0;
    if (un < NUN) { MIX_LOAD(un); MIX_FILL(un, Vb); if (un + G < NUN) MIX_LOAD(un + G); }
    LDS_BAR();
    for (; un < NUN; un += G, cur ^= 1) {
        const int rc = un >> 4, g = (un >> 2) & 3, cs = un & 3; const bool samp = rc >= 128; const int colb = g * 512 + cs * 128;
        LAS unsigned char* Vl = Vb + cur * VBUF;
        const int var = g * 2 + (samp ? 1 : 0);
        if (var != wvar) { wvar = var; const bf16_t* wt = wtri + (size_t)var * 16384;
#pragma unroll
            for (int k = 0; k < 4; ++k) { const int ci = tid + 512 * k, t = ci >> 4, q = ci & 15; *(LAS u32x4*)(Wl + t * WPITCH + q * 16) = *(const u32x4*)(wt + t * 128 + q * 8); }
            LDS_BAR(); }
        const int cp = wave & 3, th = wave >> 2;
        u32x4 uws[4]; float bss[4];
#pragma unroll
        for (int q = 0; q < 4; ++q) { const int tt = (q & 1) ? (th ? 2 + 4 * (q >> 1) : 3 + 4 * (q >> 1)) : (th ? 1 + 4 * (q >> 1) : 4 * (q >> 1)); const int t = tt * 16 + fr;
            uws[q] = *(const u32x4*)(U + (size_t)(rc * 128 + t) * DSGU + colb + cp * 32 + 8 * fq); bss[q] = bsp[g * 128 + (samp ? (t & 7) : t)]; }
        if (un + G < NUN) { MIX_FILL(un + G, Vb + (cur ^ 1) * VBUF); if (un + 2 * G < NUN) MIX_LOAD(un + 2 * G); }
        bf16x8 vfa[4], vfb[4];
        { const int ca = cp * 32 + 8 * (fr >> 2) + (fr & 3), cb = ca + 4;
#pragma unroll
            for (int ks = 0; ks < 4; ++ks) { const int go = (((4 * ks + fq) ^ (ca >> 3)) << 4); vfa[ks] = *(const LAS bf16x8*)(Vl + ca * WPITCH + go); vfb[ks] = *(const LAS bf16x8*)(Vl + cb * WPITCH + go); } }
#pragma unroll
        for (int q = 0; q < 4; ++q) { const int tt = (q & 1) ? (th ? 2 + 4 * (q >> 1) : 3 + 4 * (q >> 1)) : (th ? 1 + 4 * (q >> 1) : 4 * (q >> 1));
            f32x4 acca = {0.f, 0.f, 0.f, 0.f}, accb = acca;
#pragma unroll
            for (int ks = 0; ks < 4; ++ks) if (ks <= tt / 2) { const bf16x8 wf = *(const LAS bf16x8*)(Wl + (tt * 16 + fr) * WPITCH + (32 * ks + 8 * fq) * 2);
                acca = __builtin_amdgcn_mfma_f32_16x16x32_bf16(vfa[ks], wf, acca, 0, 0, 0); accb = __builtin_amdgcn_mfma_f32_16x16x32_bf16(vfb[ks], wf, accb, 0, 0, 0); }
            const int t = tt * 16 + fr; const float bias = bss[q]; const u32x4 uw = uws[q];
            bf16_t* up = U + (size_t)(rc * 128 + t) * DSGU + colb + cp * 32 + 8 * fq;
            u32x4 w; w.x = cvt_pk_bf16(bf2f(uw.x & 0xffffu) * (acca[0] + bias), bf2f(uw.x >> 16) * (acca[1] + bias)); w.y = cvt_pk_bf16(bf2f(uw.y & 0xffffu) * (acca[2] + bias), bf2f(uw.y >> 16) * (acca[3] + bias));
            w.z = cvt_pk_bf16(bf2f(uw.z & 0xffffu) * (accb[0] + bias), bf2f(uw.z >> 16) * (accb[1] + bias)); w.w = cvt_pk_bf16(bf2f(uw.w & 0xffffu) * (accb[2] + bias), bf2f(uw.w >> 16) * (accb[3] + bias));
            *(u32x4*)(dummy ? up + (size_t)68 * MiB : up) = w; }
        LDS_BAR();
    }
#undef MIX_LOAD
#undef MIX_FILL
#undef LDS_BAR
}

#define XB_TMO      128
#define XB_XCNT(j)  (256  + 64 * (j))
#define XB_XSUB(j)  (1280 + 64 * (j))
#define XB_XGEN(j)  (2304 + 64 * (j))
#define XB_TOP      3328
#define XB_TOPGEN   3392
#define XCD_BAR_WORDS 3456
#define XB_SPIN_CAP (1u << 18)

__device__ __forceinline__ unsigned xb_ld(unsigned* p)              { return __hip_atomic_load(p, __ATOMIC_RELAXED, __HIP_MEMORY_SCOPE_AGENT); }
__device__ __forceinline__ unsigned xb_add(unsigned* p, unsigned v) { return __hip_atomic_fetch_add(p, v, __ATOMIC_RELAXED, __HIP_MEMORY_SCOPE_AGENT); }
__device__ __forceinline__ unsigned xb_xcc_id() { return (unsigned)__builtin_amdgcn_s_getreg((3 << 11) | 20) & 0xFu; }
#define XB_SPIN(cond, bar) do { unsigned _sp = 0; while (cond) { __builtin_amdgcn_s_sleep(1); \
    if ((++_sp & 255u) == 0u) { if (xb_ld(&(bar)[XB_TMO])) break; if (_sp > XB_SPIN_CAP) { atomicAdd(&(bar)[XB_TMO], 1u); break; } } } } while (0)

struct XcdBarrier {
    unsigned* bar; unsigned x;
    volatile LAS unsigned* st;
};

__device__ __forceinline__ XcdBarrier xcd_barrier_post(unsigned* bar, volatile LAS unsigned* st) {
    XcdBarrier b; b.bar = bar; b.x = xb_xcc_id(); b.st = st;
    if (threadIdx.x == 0) (void)xb_add(&bar[XB_XCNT(b.x)], 1u);
    return b;
}
__device__ __forceinline__ void xcd_barrier_complete(unsigned* bar, unsigned x, unsigned& nloc, unsigned& nx) {
    const unsigned G = gridDim.x * gridDim.y * gridDim.z;
    unsigned sum, cnt, mine, sp = 0u;
    for (;;) {
        sum = 0u; cnt = 0u; mine = 0u;
#pragma unroll
        for (unsigned j = 0; j < 16; ++j) { const unsigned c = xb_ld(&bar[XB_XCNT(j)]); sum += c; cnt += (c > 0u) ? 1u : 0u; mine = (j == x) ? c : mine; }
        if (sum == G) break;
        __builtin_amdgcn_s_sleep(1);
        if ((++sp & 255u) == 0u) { if (xb_ld(&bar[XB_TMO])) break; if (sp > XB_SPIN_CAP) { atomicAdd(&bar[XB_TMO], 1u); break; } }
    }
    nloc = mine > 0u ? mine : 1u; nx = cnt > 0u ? cnt : 1u;
}

__device__ __forceinline__ void xcd_barrier(const XcdBarrier& b) {
    asm volatile("s_waitcnt vmcnt(0)" ::: "memory");
    __syncthreads();
    if (threadIdx.x == 0) {
        unsigned* bar = b.bar;
        __builtin_amdgcn_s_waitcnt(0);
        unsigned nloc = b.st[0], nx = b.st[1];
        if (nloc == 0u) { xcd_barrier_complete(bar, b.x, nloc, nx); b.st[0] = nloc; b.st[1] = nx; }
        const unsigned old = xb_add(&bar[XB_XSUB(b.x)], 1u);
        const unsigned gen = old / nloc;
        if (old + 1u == (gen + 1u) * nloc) {
            __builtin_amdgcn_fence(__ATOMIC_RELEASE, "agent");
            asm volatile("s_waitcnt vmcnt(0)" ::: "memory");
            const unsigned og = xb_add(&bar[XB_TOP], 1u);
            const unsigned tg = og / nx;
            if (og + 1u == (tg + 1u) * nx) xb_add(&bar[XB_TOPGEN], 1u);
            else XB_SPIN(xb_ld(&bar[XB_TOPGEN]) == tg, bar);
            __builtin_amdgcn_fence(__ATOMIC_ACQUIRE, "agent");
            xb_add(&bar[XB_XGEN(b.x)], 1u);
            asm volatile("s_waitcnt vmcnt(0)" ::: "memory");
        } else {
            XB_SPIN(xb_ld(&bar[XB_XGEN(b.x)]) == gen, bar);
            __builtin_amdgcn_fence(__ATOMIC_ACQUIRE, "agent");
            asm volatile("s_waitcnt vmcnt(0)" ::: "memory");
        }
    }
    __syncthreads();
}

#ifndef DBG_REP_KIND
#define DBG_REP_KIND -1
#endif
#ifndef DBG_REP_N
#define DBG_REP_N 1
#endif
#ifndef DBG_SYNC_N
#define DBG_SYNC_N 1
#endif
#ifndef DBG_MASK
#define DBG_MASK 0xffff
#endif
#define DM_(k) ((DBG_MASK >> (k)) & 1)
constexpr int N_PHASES = 39;
__device__ __forceinline__ bool phase_active(int ph) { if (ph < 2 || ph == 38) return true; const int l = (ph - 2) / 9, k = (ph - 2) % 9; return !(((l & 1) == 0 && k == 3) || ((l & 1) == 1 && k == 2)); }
__global__ void __launch_bounds__(NTHR) fwd_kernel(Params Pval) {
    PPtr P = (PPtr)__builtin_amdgcn_kernarg_segment_ptr();
    extern __shared__ __attribute__((aligned(16))) unsigned char lds_raw[];
    LAS unsigned char* lds = (LAS unsigned char*)lds_raw;
    { int t0 = threadIdx.x; for (int u = t0; u < (LDS_BYTES - 131072) / 4; u += NTHR) ((LAS unsigned*)(lds + 131072))[u] = 0u; }
    __syncthreads();
    const XcdBarrier xbar = xcd_barrier_post((unsigned*)P->ws + 4096, (volatile LAS unsigned*)(lds + 131072 + 320) + 8);
    const int ph_hi = P->ph_hi;
    for (int it = P->ph_lo * DBG_REP_N; it < ph_hi * DBG_REP_N; ++it) {
        const int ph = it / DBG_REP_N;
        if (!phase_active(ph)) continue;
        asm volatile("" : "+s"(P));
        int tid = threadIdx.x; asm volatile("" : "+v"(tid)); const int lane = tid & 63, wave = __builtin_amdgcn_readfirstlane(tid >> 6);
        int G = gridDim.x, bx = blockIdx.x; asm volatile("" : "+s"(G), "+s"(bx)); const int vcu = (G % 8 == 0) ? (bx % 8) * (G / 8) + bx / 8 : bx;
        unsigned char* ws = P->ws; float* mod = (float*)(ws + WS_MOD); const bf16_t* XN = (const bf16_t*)(ws + WS_R2);
        const int gw = vcu * NWAVES + wave, NGW = G * NWAVES;
        int kind, l = 0, li = 0, k = 0;
        if (ph == 0) kind = 0; else if (ph == 1) kind = 1; else if (ph == 38) kind = 2;
        else { l = (ph - 2) / 9; k = (ph - 2) % 9; li = l >> 1; const bool attn = (l & 1) == 0;
            kind = (k == 0 || k == 5) ? 2 : k == 1 ? (attn ? 3 : 6) : k == 2 ? (attn ? 4 : 7) : k == 3 ? 8 : (k == 4 || k == 8) ? 5 : k == 6 ? 9 : 10; }
        if (it % DBG_REP_N != 0 && !(kind == DBG_REP_KIND && ph != 38)) continue;
        if (kind == 0) { if (DM_(0)) prologue_phase(P, lds, gw, NGW, lane, wave); }
        else if (kind == 1) { if (DM_(1)) { pg8::Gemm g{(const bf16_t*)(ws + WS_SC), (const bf16_t*)(ws + WS_R1), 256, MODW, DM}; pg8::StaticOrder S; S.init(256, MODW, G, bx);
            EpiAda E{mod, P->in[I_BADA]}; pg8::gemm_phase<EpiAda, pg8::StaticOrder, true, true>(lds, g, S, E); } }
        else if (kind == 2) { if (DM_(2)) norm_phase(P, l, ph == 38 ? 2 : (k == 5 ? 1 : 0), ph == 2, ph == 2 ? 0 : (ph == 38 || k == 0) ? 11 : 8, gw, NGW, lane); }
        else if (kind == 3) { if (DM_(3)) { pg8::Gemm g{XN, (const bf16_t*)(ws + WS_WQKV) + (size_t)li * QKVN * DM, M, QKVN, DM}; pg8::StaticOrder S; S.init(M, QKVN, G, bx);
            EpiQKV E{(bf16_t*)(ws + WS_R1), (bf16_t*)(ws + WS_R1 + 34 * MiB), (bf16_t*)(ws + WS_R1 + 43 * MiB), P->in[I_BQKV] + li * QKVN, (const float*)(ws + WS_ROPE),
                     P->out + O_KP + (size_t)li * 65536, P->out + O_VP + (size_t)li * 65536, P->out + O_KS + (size_t)li * 4194304, P->out + O_VS + (size_t)li * 4194304};
            pg8::gemm_phase<EpiQKV, pg8::StaticOrder, true, true>(lds, g, S, E); } }
        else if (kind == 4) { if (DM_(4)) attn_phase(P, li, lds, vcu, G, tid, wave, lane); }
        else if (kind == 5) { if (DM_(5)) {
            const bf16_t* A; const bf16_t* Bt; int K; int part = 2;
            if (k == 8) { A = (const bf16_t*)(ws + WS_R2); Bt = (const bf16_t*)(ws + WS_WDN) + (size_t)l * DM * DFF; K = DFF; part = 5; }
            else if ((l & 1) == 0) { A = (const bf16_t*)(ws + WS_R1 + 52 * MiB); Bt = (const bf16_t*)(ws + WS_WO) + (size_t)li * DM * DM; K = DM; }
            else { A = (const bf16_t*)(ws + WS_R1); Bt = (const bf16_t*)(ws + WS_WSO) + (size_t)li * DM * DSGU; K = DSGU; }
            const int ns = K == DFF ? 11 : 8, ntk = K / 64 / ns;
            pg8::Gemm g{A, Bt, M, DM, K}; ResidOrder S; S.init(G, bx, ns, ntk);
            EpiResid E{P->out, (l == 0 && k == 4) ? P->in[I_XP] : (const float*)P->out, mod + l * 6144 + part * DM, (float*)(ws + WS_PART), ntk, (DBG_REP_KIND == 5 && DBG_REP_N > 1 && it % DBG_REP_N == 0) ? 0.f : 1.f}; pg8::gemm_phase<EpiResid, ResidOrder, true, true>(lds, g, S, E); } }
        else if (kind == 6) { if (DM_(6)) { pg8::Gemm g{XN, (const bf16_t*)(ws + WS_WSI) + (size_t)li * 2 * DSGU * DM, M, 2 * DSGU, DM}; pg8::StaticOrder S; S.init(M, 2 * DSGU, G, bx);
            EpiGelu E{(bf16_t*)(ws + WS_R1), (bf16_t*)(ws + WS_R1 + (size_t)M * DSGU * 2), P->in[I_BSI] + li * 2 * DSGU, (float*)(ws + WS_RSTAT) + (size_t)li * M * 2}; pg8::gemm_phase<EpiGelu, pg8::StaticOrder, true, true>(lds, g, S, E); } }
        else if (kind == 8) { if (DM_(8)) mix_phase(P, li, lds, vcu, G, tid, wave, lane, DBG_REP_KIND == 8 && DBG_REP_N > 1 && it % DBG_REP_N == 0); }
        else if (kind == 9) { if (DM_(9)) { pg8::Gemm g{XN, (const bf16_t*)(ws + WS_WUP) + (size_t)l * DFF2 * DM, M, DFF2, DM}; pg8::StaticOrder S; S.init(M, DFF2, G, bx);
            EpiUp E{(bf16_t*)(ws + WS_R1), P->out + O_CP + (size_t)l * 2 * 2 * DFF2, P->out + O_CS + (size_t)l * 128 * 2 * DFF2}; pg8::gemm_phase<EpiUp, pg8::StaticOrder, true, true>(lds, g, S, E); } }
        else { if (DM_(10)) conv_phase(P, l, bx * NTHR + tid, G * NTHR); }
        if (it + 1 < ph_hi * DBG_REP_N) { for (int sr = 0; sr < DBG_SYNC_N; ++sr) { if (ph_hi < 0) { __syncthreads(); cg::this_grid().sync(); } else xcd_barrier(xbar); } }
    }
}

extern "C" void kernel_launch(void* const* d_in, const int* in_sizes, int n_in, void* d_out, int out_size, void* d_ws, size_t ws_size, hipStream_t stream) {
    static int grid = 0;
    if (grid == 0) {
        if (n_in != 27 || (size_t)out_size != O_END || ws_size < WS_END) { fprintf(stderr, "kernel_launch: unexpected shapes: n_in %d out %d ws %zu\n", n_in, out_size, ws_size); grid = -1; return; }
        int dev = 0, cus = 0, per_cu = 0;
        hipGetDevice(&dev); hipDeviceGetAttribute(&cus, hipDeviceAttributeMultiprocessorCount, dev);
        if (hipFuncSetAttribute((const void*)fwd_kernel, hipFuncAttributeMaxDynamicSharedMemorySize, LDS_BYTES) != hipSuccess) { fprintf(stderr, "kernel_launch: hipFuncSetAttribute failed\n"); grid = -1; return; }
        if (hipOccupancyMaxActiveBlocksPerMultiprocessor(&per_cu, (const void*)fwd_kernel, NTHR, LDS_BYTES) != hipSuccess || per_cu < 1) { fprintf(stderr, "kernel_launch: occupancy query says %d\n", per_cu); (void)hipGetLastError(); grid = -1; return; }
        grid = cus;
    }
    if (grid < 0) return;
    Params p; memset(&p, 0, sizeof(p));
    for (int i = 0; i < 27; ++i) p.in[i] = (const float*)d_in[i];
    p.out = (float*)d_out; p.ws = (unsigned char*)d_ws;
    for (int i = 0; i < 8; ++i) p.inv[i] = pow(500000.0, -(double)i / 8.0);
#if MK_PER_PHASE
    for (int ph = 0; ph < N_PHASES; ++ph) { bool act = (ph < 2 || ph == 38) || !((((ph - 2) / 9) & 1) == 0 && (ph - 2) % 9 == 3); if (!act) continue;
        p.ph_lo = ph; p.ph_hi = ph + 1; hipLaunchKernelGGL(fwd_kernel, dim3(grid), dim3(NTHR), LDS_BYTES, stream, p); }
#else
    if (hipMemsetAsync(d_ws, 0, 65536, stream) != hipSuccess) { fprintf(stderr, "kernel_launch: memset failed\n"); return; }
    p.ph_lo = 0; p.ph_hi = N_PHASES; void* args[] = {&p};
    hipError_t e = hipLaunchCooperativeKernel((const void*)fwd_kernel, dim3(grid), dim3(NTHR), args, LDS_BYTES, stream);
    if (e != hipSuccess) fprintf(stderr, "kernel_launch: cooperative launch failed: %s (grid %d)\n", hipGetErrorString(e), grid);
#endif
}
```
